# Optimizing an MI355X kernel written in HIP

```python
import jax, jax.numpy as jnp
from jax import lax
import numpy as np

D_MODEL = 1024
BATCH = 8
SEQ = 2048
DEPTH = 1
DEC_BATCH = 128
DEC_SEQ = 8
PAST_LEN = 16384
PAGE_SIZE = 128

CONV_WIDTH = D_MODEL
CONV_W = 3
POOL_WIDTH = D_MODEL
POOL_WINDOWS = (2, 4, 8, 16)
N_POOL_GROUPS = len(POOL_WINDOWS)
POOL_GW = POOL_WIDTH // N_POOL_GROUPS
POOL_GW_OUT = D_MODEL // N_POOL_GROUPS
POOL_BUF = max(POOL_WINDOWS) - 1
D_FF = 4 * D_MODEL
PLE_DIM = 256
EPS = 1e-6
IN_COLS = 3 * CONV_WIDTH + POOL_WIDTH + 2 * D_MODEL

kernel_name = "hybrid_shortconv_pool_decoder_step"


def rms_norm(x, g):
    xf = x.astype(jnp.float32)
    xf = xf * lax.rsqrt(jnp.mean(xf * xf, axis=-1, keepdims=True) + EPS)
    return xf.astype(x.dtype) * g


def gated_short_conv(b, c, h, buf, w_conv):
    u = c * h
    ext = jnp.concatenate([buf, u], axis=1)
    T = u.shape[1]
    y = sum(ext[:, k:k + T] * w_conv[k] for k in range(CONV_W))
    return b * y, ext[:, -(CONV_W - 1):]


def multiscale_pool(v, buf, pos0, w_pool, pool_scale):
    Bn, T, _ = v.shape
    ext = jnp.concatenate([buf, v], axis=1)
    cs = jnp.cumsum(ext.astype(jnp.float32), axis=1)
    cs0 = jnp.concatenate([jnp.zeros((Bn, 1, POOL_WIDTH), jnp.float32), cs], axis=1)
    end = cs0[:, POOL_BUF + 1:POOL_BUF + 1 + T]
    pos = (pos0 + jnp.arange(T)).astype(jnp.float32)
    outs = []
    for gi, w in enumerate(POOL_WINDOWS):
        sl = slice(gi * POOL_GW, (gi + 1) * POOL_GW)
        s = end[..., sl] - cs0[:, POOL_BUF + 1 - w:POOL_BUF + 1 - w + T, sl]
        cnt = jnp.minimum(jnp.float32(w), pos + 1.0)[None, :, None]
        outs.append(s / cnt)
    pooled = jnp.concatenate(outs, axis=-1) - v.astype(jnp.float32)
    pooled = pooled.astype(v.dtype).reshape(Bn, T, N_POOL_GROUPS, POOL_GW)
    y = jnp.einsum('btgc,gcd->btgd', pooled, w_pool).reshape(Bn, T, D_MODEL)
    return y * pool_scale, ext[:, -POOL_BUF:]


def trunk(x, p, conv_bufs, pool_bufs, pos0, g_mix, w_in, w_conv, w_out_conv, w_pool,
          pool_scale, w_o, g_mlp, w_up, w_down, g_ple, w_ple_gate, w_ple_proj, g_final):
    h = x
    new_conv, new_pool = [], []
    o1, o2, o3 = CONV_WIDTH, 2 * CONV_WIDTH, 3 * CONV_WIDTH
    o4 = o3 + POOL_WIDTH
    o5 = o4 + D_MODEL
    for i in range(DEPTH):
        xn = rms_norm(h, g_mix[i])
        z = xn @ w_in[i]
        b, c, hc = z[..., :o1], z[..., o1:o2], z[..., o2:o3]
        v = z[..., o3:o4]
        gate_a = jax.nn.sigmoid(z[..., o4:o5])
        gate_b = jax.nn.sigmoid(z[..., o5:])
        ya, cb = gated_short_conv(b, c, hc, conv_bufs[i], w_conv[i])
        ya = ya @ w_out_conv[i]
        yb, pb = multiscale_pool(v, pool_bufs[i], pos0, w_pool[i], pool_scale[i])
        h = h + (gate_a * ya + gate_b * yb) @ w_o[i]
        new_conv.append(cb)
        new_pool.append(pb)
        hn = rms_norm(h, g_mlp[i])
        h = h + jnp.square(jax.nn.relu(hn @ w_up[i])) @ w_down[i]
        gp = jax.nn.sigmoid(rms_norm(h, g_ple[i]) @ w_ple_gate[i])
        h = h + gp * (p[i] @ w_ple_proj[i])
    return rms_norm(h, g_final), jnp.stack(new_conv), jnp.stack(new_pool)


def setup_inputs(seed: int = 0) -> dict:
    key = jax.random.key(seed)
    ks = jax.random.split(key, 24)
    f32 = jnp.float32

    def nrm(k, shape, scale):
        return jax.random.normal(k, shape, f32) * scale

    def gain(k, shape):
        return 1.0 + 0.05 * jax.random.normal(k, shape, f32)

    return {
        "x_prompt": nrm(ks[0], (BATCH, SEQ, D_MODEL), 1.0),
        "x_sample": nrm(ks[1], (DEC_BATCH, DEC_SEQ, D_MODEL), 1.0),
        "state_conv": nrm(ks[2], (DEPTH, DEC_BATCH, CONV_W - 1, CONV_WIDTH), 1.0),
        "state_pool": nrm(ks[3], (DEPTH, DEC_BATCH, POOL_BUF, POOL_WIDTH), 1.0),
        "p_prompt": nrm(ks[4], (DEPTH, BATCH, SEQ, PLE_DIM), 1.0),
        "p_sample": nrm(ks[5], (DEPTH, DEC_BATCH, DEC_SEQ, PLE_DIM), 1.0),
        "g_mix": gain(ks[6], (DEPTH, D_MODEL)),
        "w_in": nrm(ks[7], (DEPTH, D_MODEL, IN_COLS), D_MODEL ** -0.5),
        "w_conv": nrm(ks[8], (DEPTH, CONV_W, CONV_WIDTH), CONV_W ** -0.5),
        "w_out_conv": nrm(ks[9], (DEPTH, CONV_WIDTH, D_MODEL), CONV_WIDTH ** -0.5),
        "w_pool": nrm(ks[10], (DEPTH, N_POOL_GROUPS, POOL_GW, POOL_GW_OUT), POOL_GW ** -0.5),
        "pool_scale": gain(ks[11], (DEPTH, D_MODEL)),
        "w_o": nrm(ks[12], (DEPTH, D_MODEL, D_MODEL), D_MODEL ** -0.5),
        "g_mlp": gain(ks[13], (DEPTH, D_MODEL)),
        "w_up": nrm(ks[14], (DEPTH, D_MODEL, D_FF), D_MODEL ** -0.5),
        "w_down": nrm(ks[15], (DEPTH, D_FF, D_MODEL), D_FF ** -0.5),
        "g_ple": gain(ks[16], (DEPTH, D_MODEL)),
        "w_ple_gate": nrm(ks[17], (DEPTH, D_MODEL, D_MODEL), D_MODEL ** -0.5),
        "w_ple_proj": nrm(ks[18], (DEPTH, PLE_DIM, D_MODEL), PLE_DIM ** -0.5),
        "g_final": gain(ks[19], (D_MODEL,)),
    }


def reference(x_prompt, x_sample, state_conv, state_pool, p_prompt, p_sample, g_mix, w_in,
              w_conv, w_out_conv, w_pool, pool_scale, w_o, g_mlp, w_up, w_down, g_ple,
              w_ple_gate, w_ple_proj, g_final):
    zero_conv = jnp.zeros((DEPTH, x_prompt.shape[0], CONV_W - 1, CONV_WIDTH), x_prompt.dtype)
    zero_pool = jnp.zeros((DEPTH, x_prompt.shape[0], POOL_BUF, POOL_WIDTH), x_prompt.dtype)
    y_prompt, new_conv_prompt, new_pool_prompt = trunk(
        x_prompt, p_prompt, zero_conv, zero_pool, 0, g_mix, w_in, w_conv, w_out_conv,
        w_pool, pool_scale, w_o, g_mlp, w_up, w_down, g_ple, w_ple_gate, w_ple_proj, g_final)
    y_sample, new_conv_sample, new_pool_sample = trunk(
        x_sample, p_sample, state_conv, state_pool, PAST_LEN, g_mix, w_in, w_conv, w_out_conv,
        w_pool, pool_scale, w_o, g_mlp, w_up, w_down, g_ple, w_ple_gate, w_ple_proj, g_final)
    return (y_prompt, y_sample, new_conv_prompt, new_pool_prompt, new_conv_sample, new_pool_sample)
```

```cpp
#include <hip/hip_runtime.h>
#include <cstdio>
#include <cstdint>

#ifndef MK_N_LAUNCHES
#define MK_N_LAUNCHES 1
#endif

namespace pg8 {
#define PG8_LAS __attribute__((address_space(3)))
typedef unsigned short bf16_t;
typedef short bf16x8 __attribute__((ext_vector_type(8)));
typedef float f32x4 __attribute__((ext_vector_type(4)));
typedef unsigned u32x4 __attribute__((ext_vector_type(4)));
constexpr int BM = 256, BK = 64, HALF = 128, HTB = HALF * BK * 2, STAGE_BYTES = 8 * HTB, NXCD = 8, WGM = 8;

__host__ __device__ __forceinline__ int lds_byte(int r, int c) { const int st = (r >> 4) * 2 + (c >> 5), rr = r & 15, cc = c & 31, ob = rr * 64 + cc * 2; return st * 1024 + (ob ^ (((ob >> 9) & 1) << 5)); }
__host__ __device__ __forceinline__ void stage_rc(int b, int& R, int& C) { const int st = b / 1024, sb = b % 1024, swz = sb ^ (((sb >> 9) & 1) << 5); R = (st >> 1) * 16 + swz / 64; C = (st & 1) * 32 + (swz % 64) / 2; }
__host__ __device__ __forceinline__ int perm32(int rho) { const int n = rho >> 4, i = rho & 15; return 8 * (i >> 2) + 4 * n + (i & 3); }

struct Unit { int pm, pn; };
struct Gemm { const bf16_t* A; const bf16_t* Bt; int K, lda, ldb, a_pn_off; };

struct StaticOrder {
    int nM, nN, nwg, G, c;
    __host__ __device__ void init(int M, int N, int G_, int c_) { nM = M / BM; nN = N / BM; nwg = nM * nN; G = G_; c = c_; }
    __host__ __device__ bool next(int i, Unit& u) const {
        const long L = (long)i * G + c; if (L >= nwg) return false;
        int wgid = (int)L; { const int q = nwg / NXCD, r = nwg % NXCD, xcd = wgid % NXCD, off = wgid / NXCD; wgid = (xcd < r ? xcd * (q + 1) : r * (q + 1) + (xcd - r) * q) + off; }
        const int nig = WGM * nN, gid = wgid / nig, fm = gid * WGM, gsz = (nM - fm) < WGM ? (nM - fm) : WGM;
        u.pm = fm + ((wgid % nig) % gsz); u.pn = (wgid % nig) / gsz; return true;
    }
};

__device__ __forceinline__ unsigned cvt_pk_bf16(float lo, float hi) { unsigned r; asm volatile("v_cvt_pk_bf16_f32 %0, %1, %2" : "=v"(r) : "v"(lo), "v"(hi)); return r; }
__device__ __forceinline__ u32x4 pack8(const f32x4 v0, const f32x4 v1) { u32x4 w; w.x = cvt_pk_bf16(v0[0], v0[1]); w.y = cvt_pk_bf16(v0[2], v0[3]); w.z = cvt_pk_bf16(v1[0], v1[1]); w.w = cvt_pk_bf16(v1[2], v1[3]); return w; }
__device__ __forceinline__ void unpack8(const u32x4 w, f32x4& v0, f32x4& v1) {
    v0[0] = __uint_as_float(w.x << 16); v0[1] = __uint_as_float(w.x & 0xffff0000u); v0[2] = __uint_as_float(w.y << 16); v0[3] = __uint_as_float(w.y & 0xffff0000u);
    v1[0] = __uint_as_float(w.z << 16); v1[1] = __uint_as_float(w.z & 0xffff0000u); v1[2] = __uint_as_float(w.w << 16); v1[3] = __uint_as_float(w.w & 0xffff0000u);
}
__device__ __forceinline__ int fresh_lane() { int l; asm volatile("v_mbcnt_lo_u32_b32 %0, -1, 0\n\tv_mbcnt_hi_u32_b32 %0, -1, %0" : "=v"(l)); return l; }
__device__ __forceinline__ float sigm(float x) { return __builtin_amdgcn_rcpf(1.0f + __expf(-x)); }
__device__ __forceinline__ f32x4 sigm4(f32x4 v) { f32x4 o; o[0] = sigm(v[0]); o[1] = sigm(v[1]); o[2] = sigm(v[2]); o[3] = sigm(v[3]); return o; }
__device__ __forceinline__ float ld_agent(const float* p) { return __hip_atomic_load(p, __ATOMIC_RELAXED, __HIP_MEMORY_SCOPE_AGENT); }


struct EpiIn {
    static constexpr bool PERM = true;
    bf16_t *Bb, *Ub, *Vb, *GA, *GB;
    __device__ __forceinline__ void operator()(const f32x4 (&acc)[2][2][4][2], const Unit& u, int wr, int wc, int fr, int fq) const {
        const int row0 = u.pm * BM + wr * 64 + fr, pn = u.pn;
        if (pn >= 4 && pn < 12) {
            bf16_t* base = Ub + (size_t)row0 * 1024 + (pn - 4) * 128 + wc * 32 + 8 * fq;
#pragma unroll
            for (int ai = 0; ai < 2; ++ai)
#pragma unroll
                for (int m = 0; m < 4; ++m) *(u32x4*)(base + (size_t)(ai * HALF + m * 16) * 1024) = pack8(acc[ai][0][m][0] * acc[ai][1][m][0], acc[ai][0][m][1] * acc[ai][1][m][1]);
        } else {
            bf16_t* dst; int colt; bool sg = false;
            if (pn < 4) { dst = Bb; colt = pn * 256; } else if (pn < 16) { dst = Vb; colt = (pn - 12) * 256; } else if (pn < 20) { dst = GA; colt = (pn - 16) * 256; sg = true; } else { dst = GB; colt = (pn - 20) * 256; sg = true; }
            bf16_t* base = dst + (size_t)row0 * 1024 + colt + wc * 32 + 8 * fq;
#pragma unroll
            for (int ai = 0; ai < 2; ++ai)
#pragma unroll
                for (int m = 0; m < 4; ++m)
#pragma unroll
                    for (int bj = 0; bj < 2; ++bj) { f32x4 v0 = acc[ai][bj][m][0], v1 = acc[ai][bj][m][1]; if (sg) { v0 = sigm4(v0); v1 = sigm4(v1); }
                        *(u32x4*)(base + (size_t)(ai * HALF + m * 16) * 1024 + bj * HALF) = pack8(v0, v1); }
        }
    }
};
struct EpiStore {
    static constexpr bool PERM = true;
    bf16_t* O; int ldc;
    __device__ __forceinline__ void operator()(const f32x4 (&acc)[2][2][4][2], const Unit& u, int wr, int wc, int fr, int fq) const {
        bf16_t* base = O + (size_t)(u.pm * BM + wr * 64 + fr) * ldc + u.pn * BM + wc * 32 + 8 * fq;
#pragma unroll
        for (int ai = 0; ai < 2; ++ai)
#pragma unroll
            for (int m = 0; m < 4; ++m)
#pragma unroll
                for (int bj = 0; bj < 2; ++bj) *(u32x4*)(base + (size_t)(ai * HALF + m * 16) * ldc + bj * HALF) = pack8(acc[ai][bj][m][0], acc[ai][bj][m][1]);
    }
};
template <bool ADD> struct EpiGate {
    static constexpr bool PERM = true;
    const bf16_t* gate; const bf16_t* add; bf16_t* O;
    __device__ __forceinline__ void operator()(const f32x4 (&acc)[2][2][4][2], const Unit& u, int wr, int wc, int fr, int fq) const {
        const size_t off0 = (size_t)(u.pm * BM + wr * 64 + fr) * 1024 + u.pn * BM + wc * 32 + 8 * fq;
#pragma unroll
        for (int ai = 0; ai < 2; ++ai)
#pragma unroll
            for (int m = 0; m < 4; ++m)
#pragma unroll
                for (int bj = 0; bj < 2; ++bj) { const size_t off = off0 + (size_t)(ai * HALF + m * 16) * 1024 + bj * HALF;
                    f32x4 g0, g1; unpack8(*(const u32x4*)(gate + off), g0, g1);
                    f32x4 v0 = g0 * acc[ai][bj][m][0], v1 = g1 * acc[ai][bj][m][1];
                    if (ADD) { f32x4 a0, a1; unpack8(*(const u32x4*)(add + off), a0, a1); v0 += a0; v1 += a1; }
                    *(u32x4*)(O + off) = pack8(v0, v1); asm volatile("" ::: "memory"); }
    }
};
struct EpiRes {
    static constexpr bool PERM = true;
    const float* base_p; const float* base_s; int mp_tiles; float* hout; bf16_t* hb; float* ss;
    __device__ __forceinline__ void operator()(const f32x4 (&acc)[2][2][4][2], const Unit& u, int wr, int wc, int fr, int fq) const {
        const int rloc = wr * 64 + fr, col = u.pn * BM + wc * 32 + 8 * fq;
        const float* bsrc = u.pm < mp_tiles ? base_p + (size_t)(u.pm * BM) * 1024 : base_s + (size_t)((u.pm - mp_tiles) * BM) * 1024;
#pragma unroll
        for (int ai = 0; ai < 2; ++ai)
#pragma unroll
            for (int m = 0; m < 4; ++m) { const int rl = rloc + ai * HALF + m * 16; const size_t go = (size_t)(u.pm * BM + rl) * 1024 + col; float s = 0.f;
#pragma unroll
                for (int bj = 0; bj < 2; ++bj) { const float* bp = bsrc + (size_t)rl * 1024 + col + bj * HALF;
                    const f32x4 h0 = *(const f32x4*)bp + acc[ai][bj][m][0], h1 = *(const f32x4*)(bp + 4) + acc[ai][bj][m][1];
                    *(f32x4*)(hout + go + bj * HALF) = h0; *(f32x4*)(hout + go + bj * HALF + 4) = h1; *(u32x4*)(hb + go + bj * HALF) = pack8(h0, h1);
                    s += (h0[0] * h0[0] + h0[1] * h0[1]) + (h0[2] * h0[2] + h0[3] * h0[3]) + (h1[0] * h1[0] + h1[1] * h1[1]) + (h1[2] * h1[2] + h1[3] * h1[3]); }
                s += __shfl_xor(s, 16); s += __shfl_xor(s, 32);
                if (fq == 0) __hip_atomic_fetch_add(ss + u.pm * BM + rl, s, __ATOMIC_RELAXED, __HIP_MEMORY_SCOPE_AGENT);
                asm volatile("" ::: "memory"); }
    }
};
struct EpiUp {
    static constexpr bool PERM = true;
    const float* ss; bf16_t* O;
    __device__ __forceinline__ void operator()(const f32x4 (&acc)[2][2][4][2], const Unit& u, int wr, int wc, int fr, int fq) const {
        const int row0 = u.pm * BM + wr * 64 + fr;
        bf16_t* base = O + (size_t)row0 * 4096 + u.pn * BM + wc * 32 + 8 * fq;
#pragma unroll
        for (int ai = 0; ai < 2; ++ai)
#pragma unroll
            for (int m = 0; m < 4; ++m) { const float rs = __builtin_amdgcn_rsqf(ld_agent(ss + row0 + ai * HALF + m * 16) * (1.0f / 1024.0f) + 1e-6f);
#pragma unroll
                for (int bj = 0; bj < 2; ++bj) { f32x4 v0 = acc[ai][bj][m][0] * rs, v1 = acc[ai][bj][m][1] * rs;
#pragma unroll
                    for (int j = 0; j < 4; ++j) { v0[j] = fmaxf(v0[j], 0.f); v1[j] = fmaxf(v1[j], 0.f); }
                    *(u32x4*)(base + (size_t)(ai * HALF + m * 16) * 4096 + bj * HALF) = pack8(v0 * v0, v1 * v1); } }
    }
};
struct EpiPle {
    static constexpr bool PERM = true;
    const float* ss_in; const bf16_t* PP; float* h; float* ss_out;
    __device__ __forceinline__ void operator()(const f32x4 (&acc)[2][2][4][2], const Unit& u, int wr, int wc, int fr, int fq) const {
        const int row0 = u.pm * BM + wr * 64 + fr, col = u.pn * BM + wc * 32 + 8 * fq;
#pragma unroll
        for (int ai = 0; ai < 2; ++ai)
#pragma unroll
            for (int m = 0; m < 4; ++m) { const int row = row0 + ai * HALF + m * 16; const size_t go = (size_t)row * 1024 + col; float s = 0.f;
                const float rs = __builtin_amdgcn_rsqf(ld_agent(ss_in + row) * (1.0f / 1024.0f) + 1e-6f);
#pragma unroll
                for (int bj = 0; bj < 2; ++bj) { f32x4 p0, p1; unpack8(*(const u32x4*)(PP + go + bj * HALF), p0, p1);
                    float* hp = h + go + bj * HALF;
                    const f32x4 h0 = *(const f32x4*)hp + sigm4(acc[ai][bj][m][0] * rs) * p0, h1 = *(const f32x4*)(hp + 4) + sigm4(acc[ai][bj][m][1] * rs) * p1;
                    *(f32x4*)hp = h0; *(f32x4*)(hp + 4) = h1;
                    s += (h0[0] * h0[0] + h0[1] * h0[1]) + (h0[2] * h0[2] + h0[3] * h0[3]) + (h1[0] * h1[0] + h1[1] * h1[1]) + (h1[2] * h1[2] + h1[3] * h1[3]); }
                s += __shfl_xor(s, 16); s += __shfl_xor(s, 32);
                if (fq == 0) __hip_atomic_fetch_add(ss_out + row, s, __ATOMIC_RELAXED, __HIP_MEMORY_SCOPE_AGENT);
                asm volatile("" ::: "memory"); }
    }
};

template <class Epi, class Sched, bool ALIGN_EPI>
__device__ __forceinline__ void gemm_phase(PG8_LAS unsigned char* lds, const Gemm g, const Sched& S, const Epi& E, const int wid) {
    const int lane = fresh_lane(), tid = wid * 64 + lane, wr = wid >> 2, wc = wid & 3, fr = lane & 15, fq = lane >> 4;
    const int K = g.K, nt = K / BK;
    unsigned voffA[2], voffB[2];
#pragma unroll
    for (int i = 0; i < 2; ++i) { int R, C; stage_rc(tid * 16 + i * 8192, R, C); const int Rb = Epi::PERM ? ((R & ~31) + perm32(R & 31)) : R;
        voffA[i] = (unsigned)(R * g.lda + C) * 2u; voffB[i] = (unsigned)(Rb * g.ldb + C) * 2u; }
    const size_t kstep = (size_t)(BK * 2);
    const size_t hstepA = (size_t)HALF * g.lda * 2, hstepB = (size_t)HALF * g.ldb * 2;
    const size_t tstepA = 2 * hstepA, tstepB = 2 * hstepB, pnA = (size_t)g.a_pn_off * 2;
    const unsigned ldsw = (unsigned)wid * 1024u;
    const int aoff = lds_byte(wr * 64 + fr, fq * 8), boff = lds_byte(wc * 32 + fr, fq * 8);
#define PG8_SA(b, h) (((b) * 2 + (h)) * HTB)
#define PG8_SB(b, h) ((4 + (b) * 2 + (h)) * HTB)
#define PG8_STAGE(bufoff, gbase, voff) do { _Pragma("unroll") for (int _i = 0; _i < 2; ++_i) \
        __builtin_amdgcn_global_load_lds((const unsigned*)((const char*)(gbase) + (voff)[_i]), (PG8_LAS unsigned*)(lds + (bufoff) + ldsw + _i * 8192), 16, 0, 0); } while (0)
#define PG8_LDA(dst, b, h) do { _Pragma("unroll") for (int m = 0; m < 4; ++m) _Pragma("unroll") for (int k = 0; k < 2; ++k) dst[m][k] = *(const PG8_LAS bf16x8*)(lds + PG8_SA(b, h) + aoff + m * 2048 + k * 1024); } while (0)
#define PG8_LDB(dst, b, h) do { _Pragma("unroll") for (int n = 0; n < 2; ++n) _Pragma("unroll") for (int k = 0; k < 2; ++k) dst[n][k] = *(const PG8_LAS bf16x8*)(lds + PG8_SB(b, h) + boff + n * 2048 + k * 1024); } while (0)
#define PG8_MMA(ai, bj, At, Bt) do { __builtin_amdgcn_s_setprio(1); _Pragma("unroll") for (int m = 0; m < 4; ++m) _Pragma("unroll") for (int n = 0; n < 2; ++n) _Pragma("unroll") for (int k = 0; k < 2; ++k) \
        acc[ai][bj][m][n] = __builtin_amdgcn_mfma_f32_16x16x32_bf16(Bt[n][k], At[m][k], acc[ai][bj][m][n], 0, 0, 0); __builtin_amdgcn_s_setprio(0); } while (0)
#define PG8_WAIT_V(n) asm volatile("s_waitcnt vmcnt(" #n ")" ::: "memory")
#define PG8_WAIT_L(n) asm volatile("s_waitcnt lgkmcnt(" #n ")" ::: "memory")
#define PG8_BAR __builtin_amdgcn_s_barrier()
#define PG8_SCHED __builtin_amdgcn_sched_barrier(0)
    Unit cur, nxt; int ui = 0;
    if (!S.next(0, cur)) return;
    f32x4 acc[2][2][4][2];
#pragma unroll
    for (int a = 0; a < 2; ++a)
#pragma unroll
        for (int b = 0; b < 2; ++b)
#pragma unroll
            for (int m = 0; m < 4; ++m)
#pragma unroll
                for (int n = 0; n < 2; ++n) acc[a][b][m][n] = (f32x4){0.f, 0.f, 0.f, 0.f};
    bf16x8 At[4][2], B0[2][2], B1[2][2];
    const char* cA = (const char*)g.A + (size_t)cur.pm * tstepA + (size_t)cur.pn * pnA; const char* cB = (const char*)g.Bt + (size_t)cur.pn * tstepB;
    PG8_STAGE(PG8_SB(0, 0), cB, voffB); PG8_STAGE(PG8_SB(0, 1), cB + hstepB, voffB); PG8_STAGE(PG8_SA(0, 0), cA, voffA); PG8_STAGE(PG8_SA(0, 1), cA + hstepA, voffA);
    if (wr == 1) PG8_BAR;
    PG8_WAIT_V(2); PG8_BAR;
    PG8_STAGE(PG8_SB(1, 0), cB + kstep, voffB); PG8_STAGE(PG8_SA(1, 0), cA + kstep, voffA); PG8_STAGE(PG8_SB(1, 1), cB + hstepB + kstep, voffB);
    PG8_WAIT_V(6); PG8_BAR;
    for (;;) {
        const bool has_next = S.next(ui + 1, nxt);
        const char* nA = has_next ? (const char*)g.A + (size_t)nxt.pm * tstepA + (size_t)nxt.pn * pnA : cA; const char* nB = has_next ? (const char*)g.Bt + (size_t)nxt.pn * tstepB : cB;
        for (int t = 0; t < nt; t += 2) {
            const bool last = (t == nt - 2);
            const char* a1 = cA + (size_t)(t + 1) * kstep;
            const char* a2 = last ? nA : cA + (size_t)(t + 2) * kstep; const char* b2 = last ? nB : cB + (size_t)(t + 2) * kstep;
            const char* a3 = a2 + kstep; const char* b3 = b2 + kstep;
            PG8_LDB(B0, 0, 0); PG8_LDB(B1, 0, 1); PG8_SCHED; PG8_LDA(At, 0, 0); PG8_STAGE(PG8_SA(1, 1), a1 + hstepA, voffA);
            PG8_WAIT_V(8); PG8_WAIT_L(0); PG8_BAR; PG8_MMA(0, 0, At, B0); PG8_MMA(0, 1, At, B1); PG8_BAR; PG8_SCHED;
            PG8_LDA(At, 0, 1); PG8_STAGE(PG8_SB(0, 0), b2, voffB); PG8_STAGE(PG8_SB(0, 1), b2 + hstepB, voffB); PG8_STAGE(PG8_SA(0, 0), a2, voffA);
            PG8_WAIT_V(8); PG8_WAIT_L(0); PG8_BAR; PG8_MMA(1, 0, At, B0); PG8_MMA(1, 1, At, B1); PG8_BAR; PG8_SCHED;
            PG8_LDB(B0, 1, 0); PG8_LDB(B1, 1, 1); PG8_SCHED; PG8_LDA(At, 1, 0); PG8_STAGE(PG8_SA(0, 1), a2 + hstepA, voffA);
            PG8_WAIT_V(8); PG8_WAIT_L(0); PG8_BAR; PG8_MMA(0, 0, At, B0); PG8_MMA(0, 1, At, B1); PG8_BAR; PG8_SCHED;
            PG8_LDA(At, 1, 1); PG8_STAGE(PG8_SB(1, 0), b3, voffB); PG8_STAGE(PG8_SB(1, 1), b3 + hstepB, voffB); PG8_STAGE(PG8_SA(1, 0), a3, voffA);
            PG8_WAIT_V(8); PG8_WAIT_L(0); PG8_BAR; PG8_MMA(1, 0, At, B0); PG8_MMA(1, 1, At, B1); PG8_BAR; PG8_SCHED;
        }
        if constexpr (ALIGN_EPI) { if (wr == 0) PG8_BAR; }
        { int fr_e = fr, fq_e = fq; asm volatile("" : "+v"(fr_e), "+v"(fq_e));
          E(acc, cur, wr, wc, fr_e, fq_e); }
        if (!has_next) break;
#pragma unroll
        for (int a = 0; a < 2; ++a)
#pragma unroll
            for (int b = 0; b < 2; ++b)
#pragma unroll
                for (int m = 0; m < 4; ++m)
#pragma unroll
                    for (int n = 0; n < 2; ++n) acc[a][b][m][n] = (f32x4){0.f, 0.f, 0.f, 0.f};
        cur = nxt; cA = nA; cB = nB; ++ui;
        if constexpr (ALIGN_EPI) { if (wr == 1) PG8_BAR; }
    }
    PG8_WAIT_V(0);
    if constexpr (!ALIGN_EPI) { if (wr == 0) PG8_BAR; }
    PG8_BAR;
#undef PG8_SA
#undef PG8_SB
#undef PG8_STAGE
#undef PG8_LDA
#undef PG8_LDB
#undef PG8_MMA
#undef PG8_WAIT_V
#undef PG8_WAIT_L
#undef PG8_BAR
#undef PG8_SCHED
}
}

constexpr int NWAVES = 8;
constexpr int D = 1024, MP = 8 * 2048, MS = 128 * 8, M = MP + MS, NIN = 6144, FF = 4096, PLE = 256, SEQ = 2048, DSEQ = 8, PBUF = 15;
constexpr float EPS = 1e-6f;
constexpr int N_LAUNCHES = MK_N_LAUNCHES, N_PHASES = 9;
constexpr size_t O_Y = 0, O_NCP = (size_t)M * D, O_NPP = O_NCP + 8 * 2 * D, O_NCS = O_NPP + 8 * 15 * D, O_NPS = O_NCS + 128 * 2 * D, O_END = O_NPS + 128 * 15 * D;
constexpr size_t MiB = 1u << 20, SB = (size_t)M * D * 2;
constexpr size_t WS_CTL = 0, CTL_ZERO_BYTES = 1 * MiB;
constexpr size_t WS_SS = 512 * 1024;
constexpr size_t WS_WIN = 1 * MiB, WS_WCO = 13 * MiB, WS_WO = 15 * MiB, WS_WG = 17 * MiB, WS_WUP = 19 * MiB, WS_WDN = 27 * MiB, WS_WPOOL = 35 * MiB, WS_WP = WS_WPOOL + 512 * 1024;
constexpr size_t WS_PBF = 36 * MiB;
constexpr size_t WS_PP = 45 * MiB, WS_HB = WS_PP + SB, WS_XN = WS_HB + SB, WS_B = WS_XN + SB, WS_U = WS_B + SB, WS_V = WS_U + SB, WS_END = WS_V + SB;
constexpr size_t WS_ACT = WS_XN;
static_assert(WS_SS + 3 * (size_t)M * 4 <= CTL_ZERO_BYTES && WS_PBF + (size_t)M * PLE * 2 <= WS_PP && WS_END <= 256 * MiB, "d_ws map");
constexpr int CW_BAR = 4096;
constexpr int RING_OFF = 0, RING_BYTES = 131072, LDSCTL_OFF = RING_BYTES, MISC_OFF = LDSCTL_OFF + 320, LDS_BYTES = 147456;

#define GAS __attribute__((address_space(1)))
#define LAS __attribute__((address_space(3)))
typedef unsigned short bf16;
typedef unsigned v4u __attribute__((ext_vector_type(4)));
typedef float f32x4 __attribute__((ext_vector_type(4)));
typedef GAS unsigned gu32;
#define LDS_WAIT() asm volatile("s_waitcnt lgkmcnt(0)" ::: "memory")
__device__ __forceinline__ unsigned f2bf(float f) { unsigned u = __builtin_bit_cast(unsigned, f); return (u + 0x7fffu + ((u >> 16) & 1u)) >> 16; }
__device__ __forceinline__ unsigned pk2(float lo, float hi) { return f2bf(lo) | (f2bf(hi) << 16); }

#define XB_TMO      128
#define XB_XCNT(j)  (256  + 64 * (j))
#define XB_XSUB(j)  (1280 + 64 * (j))
#define XB_XGEN(j)  (2304 + 64 * (j))
#define XB_TOP      3328
#define XB_TOPGEN   3392
#define XCD_BAR_WORDS 3456
#define XB_SPIN_CAP (1u << 18)
__device__ __forceinline__ unsigned xb_ld(unsigned* p)              { return __hip_atomic_load(p, __ATOMIC_RELAXED, __HIP_MEMORY_SCOPE_AGENT); }
__device__ __forceinline__ unsigned xb_add(unsigned* p, unsigned v) { return __hip_atomic_fetch_add(p, v, __ATOMIC_RELAXED, __HIP_MEMORY_SCOPE_AGENT); }
__device__ __forceinline__ unsigned xb_xcc_id() { return (unsigned)__builtin_amdgcn_s_getreg((3 << 11) | 20) & 0xFu; }
#define XB_SPIN(cond, bar) do { unsigned _sp = 0; while (cond) { __builtin_amdgcn_s_sleep(1); \
    if ((++_sp & 255u) == 0u) { if (xb_ld(&(bar)[XB_TMO])) break; if (_sp > XB_SPIN_CAP) { atomicAdd(&(bar)[XB_TMO], 1u); break; } } } } while (0)
struct XcdBarrier { unsigned* bar; unsigned x; volatile LAS unsigned* st; };
__device__ __forceinline__ XcdBarrier xcd_barrier_post(unsigned* bar, volatile LAS unsigned* st) {
    XcdBarrier b; b.bar = bar; b.x = xb_xcc_id(); b.st = st;
    if (threadIdx.x == 0) (void)xb_add(&bar[XB_XCNT(b.x)], 1u);
    return b;
}
__device__ __forceinline__ void xcd_barrier_complete(unsigned* bar, unsigned x, unsigned& nloc, unsigned& nx) {
    const unsigned G = gridDim.x * gridDim.y * gridDim.z;
    unsigned sum, cnt, mine, sp = 0u;
    for (;;) {
        sum = 0u; cnt = 0u; mine = 0u;
#pragma unroll
        for (unsigned j = 0; j < 16; ++j) { const unsigned c = xb_ld(&bar[XB_XCNT(j)]); sum += c; cnt += (c > 0u) ? 1u : 0u; mine = (j == x) ? c : mine; }
        if (sum == G) break;
        __builtin_amdgcn_s_sleep(1);
        if ((++sp & 255u) == 0u) { if (xb_ld(&bar[XB_TMO])) break; if (sp > XB_SPIN_CAP) { atomicAdd(&bar[XB_TMO], 1u); break; } }
    }
    nloc = mine > 0u ? mine : 1u; nx = cnt > 0u ? cnt : 1u;
}
__device__ __forceinline__ void xcd_barrier(const XcdBarrier& b, const int wave) {
    asm volatile("s_waitcnt vmcnt(0)" ::: "memory");
    __syncthreads();
    if (wave == 0 && pg8::fresh_lane() == 0) {
        unsigned* bar = b.bar;
        __builtin_amdgcn_s_waitcnt(0);
        unsigned nloc = b.st[0], nx = b.st[1];
        if (nloc == 0u) { xcd_barrier_complete(bar, b.x, nloc, nx); b.st[0] = nloc; b.st[1] = nx; }
        const unsigned old = xb_add(&bar[XB_XSUB(b.x)], 1u);
        const unsigned gen = old / nloc;
        if (old + 1u == (gen + 1u) * nloc) {
            __builtin_amdgcn_fence(__ATOMIC_RELEASE, "agent");
            asm volatile("s_waitcnt vmcnt(0)" ::: "memory");
            const unsigned og = xb_add(&bar[XB_TOP], 1u);
            const unsigned tg = og / nx;
            if (og + 1u == (tg + 1u) * nx) xb_add(&bar[XB_TOPGEN], 1u);
            else XB_SPIN(xb_ld(&bar[XB_TOPGEN]) == tg, bar);
            __builtin_amdgcn_fence(__ATOMIC_ACQUIRE, "agent");
            xb_add(&bar[XB_XGEN(b.x)], 1u);
            asm volatile("s_waitcnt vmcnt(0)" ::: "memory");
        } else {
            XB_SPIN(xb_ld(&bar[XB_XGEN(b.x)]) == gen, bar);
            __builtin_amdgcn_fence(__ATOMIC_ACQUIRE, "agent");
            asm volatile("s_waitcnt vmcnt(0)" ::: "memory");
        }
    }
    __syncthreads();
}

struct Frame {
    LAS unsigned char* lds;
    volatile LAS unsigned* MISC;
    gu32* ctl;
    int wave, vcu, G;
};
__device__ __forceinline__ float wave_sum(float v) {
#pragma unroll
    for (int o = 1; o < 64; o <<= 1) v += __shfl_xor(v, o);
    return v;
}
__device__ __forceinline__ void p0_transpose_item(const float* W, int N, bf16* WT, int ldwt, int row_off, const float* sk, const float* sn, LAS float* scr, int kb, int nb, int lane) {
    const int k0 = 64 * kb, n0 = 32 * nb;
    const float snv = sn ? sn[n0 + (lane & 31)] : 1.0f;
#pragma unroll 8
    for (int i = 0; i < 32; ++i) { const int kk = 2 * i + (lane >> 5); const float skv = sk ? sk[k0 + kk] : 1.0f; scr[kk * 33 + (lane & 31)] = W[(size_t)(k0 + kk) * N + n0 + (lane & 31)] * skv * snv; }
    LDS_WAIT(); asm volatile("" ::: "memory");
    const int c = lane & 7;
#pragma unroll
    for (int j = 0; j < 4; ++j) { const int n = (lane >> 3) + 8 * j; const LAS float* s = scr + (8 * c) * 33 + n;
        v4u o; o.x = pk2(s[0 * 33], s[1 * 33]); o.y = pk2(s[2 * 33], s[3 * 33]); o.z = pk2(s[4 * 33], s[5 * 33]); o.w = pk2(s[6 * 33], s[7 * 33]);
        *(GAS v4u*)(WT + (size_t)(row_off + n0 + n) * ldwt + k0 + 8 * c) = o; }
    LDS_WAIT(); asm volatile("" ::: "memory");
}

struct Args { const float* in[20]; float* out; unsigned char* ws; int ph_lo, ph_hi, li, pad; };

__device__ __forceinline__ void p0_prologue(Frame& F, const Args& a) {
    LAS float* scr = (LAS float*)(F.lds + RING_OFF + F.wave * 16384);
    const int lane = pg8::fresh_lane();
    const int gw = F.vcu * NWAVES + F.wave, NGW = F.G * NWAVES;
    unsigned char* ws = a.ws;
    constexpr int I_IN = 16 * (NIN / 32), I_SQ = 16 * 32, I_UP = 16 * (FF / 32), I_DN = 64 * 32, I_PL = 4 * 4 * 8, I_PP = 4 * 32;
    constexpr int NITEMS = I_IN + 3 * I_SQ + I_UP + I_DN + I_PL + I_PP;
    for (int it = gw; it < NITEMS; it += NGW) {
        int r = it;
        if (r < I_IN) {
            const int nblk = NIN / 32, kb = r / nblk, nb = r % nblk, n0 = 32 * nb; int ro;
            if (n0 < 1024 || n0 >= 3072) ro = 0; else if (n0 < 2048) { const int j = n0 - 1024; ro = (1024 + (j >> 7) * 256 + (j & 127)) - n0; } else { const int j = n0 - 2048; ro = (1024 + (j >> 7) * 256 + 128 + (j & 127)) - n0; }
            p0_transpose_item(a.in[7], NIN, (bf16*)(ws + WS_WIN), D, ro, a.in[6], nullptr, scr, kb, nb, lane); continue; } r -= I_IN;
        if (r < I_SQ) { p0_transpose_item(a.in[9], D, (bf16*)(ws + WS_WCO), D, 0, nullptr, nullptr, scr, r / 32, r % 32, lane); continue; } r -= I_SQ;
        if (r < I_SQ) { p0_transpose_item(a.in[12], D, (bf16*)(ws + WS_WO), D, 0, nullptr, nullptr, scr, r / 32, r % 32, lane); continue; } r -= I_SQ;
        if (r < I_SQ) { p0_transpose_item(a.in[17], D, (bf16*)(ws + WS_WG), D, 0, a.in[16], nullptr, scr, r / 32, r % 32, lane); continue; } r -= I_SQ;
        if (r < I_UP) { p0_transpose_item(a.in[14], FF, (bf16*)(ws + WS_WUP), D, 0, a.in[13], nullptr, scr, r / (FF / 32), r % (FF / 32), lane); continue; } r -= I_UP;
        if (r < I_DN) { p0_transpose_item(a.in[15], D, (bf16*)(ws + WS_WDN), FF, 0, nullptr, nullptr, scr, r / 32, r % 32, lane); continue; } r -= I_DN;
        if (r < I_PL) { const int g = r / 32, q = r % 32;
            p0_transpose_item(a.in[10] + (size_t)g * 65536, 256, (bf16*)(ws + WS_WPOOL), 256, g * 256, nullptr, a.in[11] + g * 256, scr, q / 8, q % 8, lane); continue; } r -= I_PL;
        p0_transpose_item(a.in[18], D, (bf16*)(ws + WS_WP), PLE, 0, nullptr, nullptr, scr, r / 32, r % 32, lane);
    }
    bf16* XN = (bf16*)(ws + WS_XN);
    for (int m = gw; m < M; m += NGW) {
        const float* xrow = m < MP ? a.in[0] + (size_t)m * D : a.in[1] + (size_t)(m - MP) * D;
        const GAS f32x4* xr = (const GAS f32x4*)xrow + lane;
        f32x4 v[4]; float s = 0.f;
#pragma unroll
        for (int j = 0; j < 4; ++j) { v[j] = xr[64 * j]; s += (v[j].x * v[j].x + v[j].y * v[j].y) + (v[j].z * v[j].z + v[j].w * v[j].w); }
        const float rstd = 1.0f / sqrtf(wave_sum(s) * (1.f / D) + EPS);
        GAS unsigned long long* o8 = (GAS unsigned long long*)(XN + (size_t)m * D) + lane;
#pragma unroll
        for (int j = 0; j < 4; ++j) o8[64 * j] = (unsigned long long)pk2(v[j].x * rstd, v[j].y * rstd) | ((unsigned long long)pk2(v[j].z * rstd, v[j].w * rstd) << 32);
    }
    bf16* PB = (bf16*)(ws + WS_PBF);
    for (int m = gw; m < M; m += NGW) {
        const float* prow = m < MP ? a.in[4] + (size_t)m * PLE : a.in[5] + (size_t)(m - MP) * PLE;
        const f32x4 v = ((const GAS f32x4*)prow)[lane];
        ((GAS unsigned long long*)(PB + (size_t)m * PLE))[lane] = (unsigned long long)pk2(v.x, v.y) | ((unsigned long long)pk2(v.z, v.w) << 32);
    }
}

__device__ __forceinline__ void p2_mixer(Frame& F, const Args& a) {
    unsigned char* ws = a.ws;
    bf16* Bb = (bf16*)(ws + WS_B); const bf16* Ub = (const bf16*)(ws + WS_U); const bf16* Vb = (const bf16*)(ws + WS_V); bf16* PO = (bf16*)(ws + WS_XN);
    const float* wconv = a.in[8]; const float* sconv = a.in[2]; const float* spool = a.in[3];
    float* out = a.out;
    const int tid_ = F.wave * 64 + pg8::fresh_lane();
    const int cc = tid_ & 127, tr = tid_ >> 7, c0 = cc * 8, grp = cc >> 5, w = 2 << grp;
    f32x4 w0a = *(const f32x4*)(wconv + c0), w0b = *(const f32x4*)(wconv + c0 + 4), w1a = *(const f32x4*)(wconv + D + c0), w1b = *(const f32x4*)(wconv + D + c0 + 4), w2a = *(const f32x4*)(wconv + 2 * D + c0), w2b = *(const f32x4*)(wconv + 2 * D + c0 + 4);
    const int rows_per = (M + F.G - 1) / F.G;
    for (int i = tr; i < rows_per; i += 4) {
        const int r = F.vcu * rows_per + i; if (r >= M) break;
        const bool samp = r >= MP; const int t = samp ? ((r - MP) & 7) : (r & (SEQ - 1)); const int sq = samp ? ((r - MP) >> 3) : (r >> 11);
        const size_t ro = (size_t)r * D + c0;
        f32x4 b0, b1, u0a, u0b, u1a, u1b, u2a, u2b;
        pg8::unpack8(*(const v4u*)(Bb + ro), b0, b1);
        pg8::unpack8(*(const v4u*)(Ub + ro), u0a, u0b);
        if (t >= 1) pg8::unpack8(*(const v4u*)(Ub + ro - D), u1a, u1b);
        else if (samp) { const float* p = sconv + ((size_t)sq * 2 + 1) * D + c0; u1a = *(const f32x4*)p; u1b = *(const f32x4*)(p + 4); }
        else { u1a = (f32x4){0.f, 0.f, 0.f, 0.f}; u1b = u1a; }
        if (t >= 2) pg8::unpack8(*(const v4u*)(Ub + ro - 2 * D), u2a, u2b);
        else if (samp) { const float* p = sconv + ((size_t)sq * 2 + t) * D + c0; u2a = *(const f32x4*)p; u2b = *(const f32x4*)(p + 4); }
        else { u2a = (f32x4){0.f, 0.f, 0.f, 0.f}; u2b = u2a; }
        const f32x4 ya = u2a * w0a + u1a * w1a + u0a * w2a, yb = u2b * w0b + u1b * w1b + u0b * w2b;
        *(v4u*)(Bb + ro) = pg8::pack8(b0 * ya, b1 * yb);
        f32x4 v0a, v0b; pg8::unpack8(*(const v4u*)(Vb + ro), v0a, v0b);
        f32x4 sa = v0a, sb = v0b;
        for (int j = 1; j < w; ++j) {
            f32x4 xa, xb;
            if (t - j >= 0) pg8::unpack8(*(const v4u*)(Vb + ro - (size_t)j * D), xa, xb);
            else if (samp) { const float* p = spool + ((size_t)sq * PBUF + (PBUF + t - j)) * D + c0; xa = *(const f32x4*)p; xb = *(const f32x4*)(p + 4); }
            else break;
            sa += xa; sb += xb;
        }
        const float cnt = samp ? (float)w : (float)(w < t + 1 ? w : t + 1);
        const float ic = 1.0f / cnt;
        *(v4u*)(PO + ro) = pg8::pack8(sa * ic - v0a, sb * ic - v0b);
        if (!samp) {
            if (t >= SEQ - 2) { float* o = out + O_NCP + ((size_t)sq * 2 + (t - (SEQ - 2))) * D + c0; *(f32x4*)o = u0a; *(f32x4*)(o + 4) = u0b; }
            if (t >= SEQ - PBUF) { float* o = out + O_NPP + ((size_t)sq * PBUF + (t - (SEQ - PBUF))) * D + c0; *(f32x4*)o = v0a; *(f32x4*)(o + 4) = v0b; }
        } else {
            if (t >= DSEQ - 2) { float* o = out + O_NCS + ((size_t)sq * 2 + (t - (DSEQ - 2))) * D + c0; *(f32x4*)o = u0a; *(f32x4*)(o + 4) = u0b; }
            { float* o = out + O_NPS + ((size_t)sq * PBUF + (PBUF - DSEQ + t)) * D + c0; *(f32x4*)o = v0a; *(f32x4*)(o + 4) = v0b; }
            if (t < PBUF - DSEQ) { const float* p = spool + ((size_t)sq * PBUF + DSEQ + t) * D + c0; float* o = out + O_NPS + ((size_t)sq * PBUF + t) * D + c0; *(f32x4*)o = *(const f32x4*)p; *(f32x4*)(o + 4) = *(const f32x4*)(p + 4); }
        }
    }
}

__device__ __forceinline__ void p8_final(Frame& F, const Args& a) {
    const int lane = pg8::fresh_lane();
    const int gw = F.vcu * NWAVES + F.wave, NGW = F.G * NWAVES;
    const float* ss = (const float*)(a.ws + WS_SS) + 2 * M; const float* gf = a.in[19];
    f32x4 g[4];
#pragma unroll
    for (int j = 0; j < 4; ++j) g[j] = ((const f32x4*)gf)[lane + 64 * j];
    for (int m = gw; m < M; m += NGW) {
        const float rs = 1.0f / sqrtf(pg8::ld_agent(ss + m) * (1.f / D) + EPS);
        GAS f32x4* hr = (GAS f32x4*)(a.out + (size_t)m * D) + lane;
#pragma unroll
        for (int j = 0; j < 4; ++j) hr[64 * j] = hr[64 * j] * rs * g[j];
    }
}

__global__ void __launch_bounds__(NWAVES * 64, 2) mega_fwd(Args args) {
    extern __shared__ __attribute__((aligned(16))) unsigned char lds[];
    Frame F;
    F.lds = (LAS unsigned char*)lds;
    F.MISC = (volatile LAS unsigned*)(F.lds + MISC_OFF);
    F.wave = __builtin_amdgcn_readfirstlane(threadIdx.x >> 6);
    F.G = gridDim.x; { const int bx = blockIdx.x; F.vcu = (F.G % 8 == 0) ? (bx % 8) * (F.G / 8) + bx / 8 : bx; }
    unsigned char* ws = args.ws;
    F.ctl = (gu32*)(ws + WS_CTL);
    for (int u = threadIdx.x; u < (LDS_BYTES - LDSCTL_OFF) / 4; u += NWAVES * 64) ((LAS unsigned*)(F.lds + LDSCTL_OFF))[u] = 0u;
    __syncthreads();
    XcdBarrier bar; bar.bar = (unsigned*)(F.ctl + CW_BAR); bar.x = 0; bar.st = nullptr;
    if (N_LAUNCHES == 1) bar = xcd_barrier_post((unsigned*)(F.ctl + CW_BAR), F.MISC + 8);
    const int lo = args.ph_lo, hi = args.ph_hi;
#define IN(k) (lo <= (k) && (k) < hi)
#define SEAM(k) do { if (IN(k) && IN((k) + 1)) xcd_barrier(bar, F.wave); } while (0)
    using namespace pg8;
    bf16_t* const W_IN = (bf16_t*)(ws + WS_WIN); bf16_t* const W_CO = (bf16_t*)(ws + WS_WCO); bf16_t* const W_O = (bf16_t*)(ws + WS_WO); bf16_t* const W_G = (bf16_t*)(ws + WS_WG);
    bf16_t* const W_UP = (bf16_t*)(ws + WS_WUP); bf16_t* const W_DN = (bf16_t*)(ws + WS_WDN); bf16_t* const W_PL = (bf16_t*)(ws + WS_WPOOL); bf16_t* const W_P = (bf16_t*)(ws + WS_WP);
    bf16_t* const PBF = (bf16_t*)(ws + WS_PBF); bf16_t* const PPB = (bf16_t*)(ws + WS_PP); bf16_t* const HB = (bf16_t*)(ws + WS_HB); bf16_t* const XN = (bf16_t*)(ws + WS_XN);
    bf16_t* const BB = (bf16_t*)(ws + WS_B); bf16_t* const UB = (bf16_t*)(ws + WS_U); bf16_t* const VB = (bf16_t*)(ws + WS_V); bf16_t* const ACT = (bf16_t*)(ws + WS_ACT);
    bf16_t* const GA = (bf16_t*)args.out; bf16_t* const GBB = GA + (size_t)M * D;
    float* const SS = (float*)(ws + WS_SS); float* const HOUT = args.out + O_Y;
    LAS unsigned char* ring = F.lds + RING_OFF;
    const int cid = (int)blockIdx.x;

    if (IN(0)) { p0_prologue(F, args); SEAM(0); }
    if (IN(1)) {
        { Gemm g{XN, W_IN, D, D, D, 0}; StaticOrder S; S.init(M, NIN, F.G, cid); EpiIn E{BB, UB, VB, GA, GBB}; gemm_phase<EpiIn, StaticOrder, true>(ring, g, S, E, F.wave); }
        { Gemm g{PBF, W_P, PLE, PLE, PLE, 0}; StaticOrder S; S.init(M, D, F.G, F.G - 1 - cid); EpiStore E{PPB, D}; gemm_phase<EpiStore, StaticOrder, true>(ring, g, S, E, F.wave); }
        SEAM(1);
    }
    if (IN(2)) { p2_mixer(F, args); SEAM(2); }
    if (IN(3)) {
        { Gemm g{XN, W_PL, 256, D, 256, 256}; StaticOrder S; S.init(M, D, F.G, cid); EpiGate<false> E{GBB, nullptr, UB}; gemm_phase<EpiGate<false>, StaticOrder, true>(ring, g, S, E, F.wave); }
        { Gemm g{BB, W_CO, D, D, D, 0}; StaticOrder S; S.init(M, D, F.G, cid); EpiGate<true> E{GA, UB, VB}; gemm_phase<EpiGate<true>, StaticOrder, true>(ring, g, S, E, F.wave); }
        SEAM(3);
    }
    if (IN(4)) { Gemm g{VB, W_O, D, D, D, 0}; StaticOrder S; S.init(M, D, F.G, cid); EpiRes E{args.in[0], args.in[1], MP / 256, HOUT, HB, SS}; gemm_phase<EpiRes, StaticOrder, true>(ring, g, S, E, F.wave); SEAM(4); }
    if (IN(5)) { Gemm g{HB, W_UP, D, D, D, 0}; StaticOrder S; S.init(M, FF, F.G, cid); EpiUp E{SS, ACT}; gemm_phase<EpiUp, StaticOrder, true>(ring, g, S, E, F.wave); SEAM(5); }
    if (IN(6)) { Gemm g{ACT, W_DN, FF, FF, FF, 0}; StaticOrder S; S.init(M, D, F.G, cid); EpiRes E{HOUT, HOUT + (size_t)MP * D, MP / 256, HOUT, HB, SS + M}; gemm_phase<EpiRes, StaticOrder, true>(ring, g, S, E, F.wave); SEAM(6); }
    if (IN(7)) { Gemm g{HB, W_G, D, D, D, 0}; StaticOrder S; S.init(M, D, F.G, cid); EpiPle E{SS + M, PPB, HOUT, SS + 2 * M}; gemm_phase<EpiPle, StaticOrder, true>(ring, g, S, E, F.wave); SEAM(7); }
    if (IN(8)) { p8_final(F, args); }
#undef IN
#undef SEAM
}

extern "C" void kernel_launch(void* const* d_in, const int* in_sizes, int n_in, void* d_out, int out_size, void* d_ws, size_t ws_size, hipStream_t stream) {
    static int grid = 0;
    if (grid == 0) {
        if (n_in != 20 || in_sizes[0] != MP * D || in_sizes[1] != MS * D || (size_t)out_size != O_END || ws_size < WS_END) {
            fprintf(stderr, "kernel_launch: unexpected shapes (n_in %d, in0 %d, out %d, ws %zu); nothing launched\n", n_in, n_in > 0 ? in_sizes[0] : -1, out_size, ws_size); grid = -1; return; }
        int dev = 0, cus = 0, per_cu = 0;
        if (hipGetDevice(&dev) != hipSuccess || hipDeviceGetAttribute(&cus, hipDeviceAttributeMultiprocessorCount, dev) != hipSuccess) { grid = -1; return; }
        if (hipFuncSetAttribute((const void*)mega_fwd, hipFuncAttributeMaxDynamicSharedMemorySize, LDS_BYTES) != hipSuccess) { fprintf(stderr, "kernel_launch: hipFuncSetAttribute failed\n"); grid = -1; return; }
        if (hipOccupancyMaxActiveBlocksPerMultiprocessor(&per_cu, (const void*)mega_fwd, NWAVES * 64, LDS_BYTES) != hipSuccess || per_cu < 1) { fprintf(stderr, "kernel_launch: occupancy query reports %d workgroups per CU\n", per_cu); }
        (void)hipGetLastError();
        grid = cus;
    }
    if (grid < 0) return;
    if (hipMemsetAsync((char*)d_ws + WS_CTL, 0, CTL_ZERO_BYTES, stream) != hipSuccess) return;
    Args a{};
    for (int i = 0; i < 20; ++i) a.in[i] = (const float*)d_in[i];
    a.out = (float*)d_out; a.ws = (unsigned char*)d_ws;
    for (int li = 0; li < N_LAUNCHES; ++li) {
        a.ph_lo = (N_LAUNCHES == 1) ? 0 : li; a.ph_hi = (N_LAUNCHES == 1) ? N_PHASES : li + 1; a.li = li;
        hipLaunchKernelGGL(mega_fwd, dim3(grid), dim3(NWAVES * 64), LDS_BYTES, stream, a);
    }
}
```

```cpp
#include <hip/hip_runtime.h>
#include <cstdio>
#include <cstdint>

#ifndef MK_N_LAUNCHES
#define MK_N_LAUNCHES 1
#endif

namespace pg8 {
#define PG8_LAS __attribute__((address_space(3)))
typedef unsigned short bf16_t;
typedef short bf16x8 __attribute__((ext_vector_type(8)));
typedef float f32x4 __attribute__((ext_vector_type(4)));
typedef unsigned u32x4 __attribute__((ext_vector_type(4)));
constexpr int BM = 256, BK = 64, HALF = 128, HTB = HALF * BK * 2, STAGE_BYTES = 8 * HTB, NXCD = 8, WGM = 8;

__host__ __device__ __forceinline__ int lds_byte(int r, int c) { const int st = (r >> 4) * 2 + (c >> 5), rr = r & 15, cc = c & 31, ob = rr * 64 + cc * 2; return st * 1024 + (ob ^ (((ob >> 9) & 1) << 5)); }
__host__ __device__ __forceinline__ void stage_rc(int b, int& R, int& C) { const int st = b / 1024, sb = b % 1024, swz = sb ^ (((sb >> 9) & 1) << 5); R = (st >> 1) * 16 + swz / 64; C = (st & 1) * 32 + (swz % 64) / 2; }
__host__ __device__ __forceinline__ int perm32(int rho) { const int n = rho >> 4, i = rho & 15; return 8 * (i >> 2) + 4 * n + (i & 3); }

struct Unit { int pm, pn; };
struct Gemm { const bf16_t* A; const bf16_t* Bt; int K, lda, ldb, a_pn_off; };

struct StaticOrder {
    int nM, nN, nwg, G, c;
    __host__ __device__ void init(int M, int N, int G_, int c_) { nM = M / BM; nN = N / BM; nwg = nM * nN; G = G_; c = c_; }
    __host__ __device__ bool next(int i, Unit& u) const {
        const long L = (long)i * G + c; if (L >= nwg) return false;
        int wgid = (int)L; { const int q = nwg / NXCD, r = nwg % NXCD, xcd = wgid % NXCD, off = wgid / NXCD; wgid = (xcd < r ? xcd * (q + 1) : r * (q + 1) + (xcd - r) * q) + off; }
        const int nig = WGM * nN, gid = wgid / nig, fm = gid * WGM, gsz = (nM - fm) < WGM ? (nM - fm) : WGM;
        u.pm = fm + ((wgid % nig) % gsz); u.pn = (wgid % nig) / gsz; return true;
    }
};

__device__ __forceinline__ unsigned cvt_pk_bf16(float lo, float hi) { unsigned r; asm volatile("v_cvt_pk_bf16_f32 %0, %1, %2" : "=v"(r) : "v"(lo), "v"(hi)); return r; }
__device__ __forceinline__ u32x4 pack8(const f32x4 v0, const f32x4 v1) { u32x4 w; w.x = cvt_pk_bf16(v0[0], v0[1]); w.y = cvt_pk_bf16(v0[2], v0[3]); w.z = cvt_pk_bf16(v1[0], v1[1]); w.w = cvt_pk_bf16(v1[2], v1[3]); return w; }
__device__ __forceinline__ void unpack8(const u32x4 w, f32x4& v0, f32x4& v1) {
    v0[0] = __uint_as_float(w.x << 16); v0[1] = __uint_as_float(w.x & 0xffff0000u); v0[2] = __uint_as_float(w.y << 16); v0[3] = __uint_as_float(w.y & 0xffff0000u);
    v1[0] = __uint_as_float(w.z << 16); v1[1] = __uint_as_float(w.z & 0xffff0000u); v1[2] = __uint_as_float(w.w << 16); v1[3] = __uint_as_float(w.w & 0xffff0000u);
}
__device__ __forceinline__ int fresh_lane() { int l; asm volatile("v_mbcnt_lo_u32_b32 %0, -1, 0\n\tv_mbcnt_hi_u32_b32 %0, -1, %0" : "=v"(l)); return l; }
__device__ __forceinline__ float sigm(float x) { return __builtin_amdgcn_rcpf(1.0f + __expf(-x)); }
__device__ __forceinline__ f32x4 sigm4(f32x4 v) { f32x4 o; o[0] = sigm(v[0]); o[1] = sigm(v[1]); o[2] = sigm(v[2]); o[3] = sigm(v[3]); return o; }
__device__ __forceinline__ float ld_agent(const float* p) { return __hip_atomic_load(p, __ATOMIC_RELAXED, __HIP_MEMORY_SCOPE_AGENT); }


struct EpiIn {
    static constexpr bool PERM = true;
    bf16_t *Bb, *Ub, *Vb, *GA, *GB;
    __device__ __forceinline__ void operator()(const f32x4 (&acc)[2][2][4][2], const Unit& u, int wr, int wc, int fr, int fq) const {
        const int row0 = u.pm * BM + wr * 64 + fr, pn = u.pn;
        if (pn >= 4 && pn < 12) {
            bf16_t* base = Ub + (size_t)row0 * 1024 + (pn - 4) * 128 + wc * 32 + 8 * fq;
#pragma unroll
            for (int ai = 0; ai < 2; ++ai)
#pragma unroll
                for (int m = 0; m < 4; ++m) *(u32x4*)(base + (size_t)(ai * HALF + m * 16) * 1024) = pack8(acc[ai][0][m][0] * acc[ai][1][m][0], acc[ai][0][m][1] * acc[ai][1][m][1]);
        } else {
            bf16_t* dst; int colt; bool sg = false;
            if (pn < 4) { dst = Bb; colt = pn * 256; } else if (pn < 16) { dst = Vb; colt = (pn - 12) * 256; } else if (pn < 20) { dst = GA; colt = (pn - 16) * 256; sg = true; } else { dst = GB; colt = (pn - 20) * 256; sg = true; }
            bf16_t* base = dst + (size_t)row0 * 1024 + colt + wc * 32 + 8 * fq;
#pragma unroll
            for (int ai = 0; ai < 2; ++ai)
#pragma unroll
                for (int m = 0; m < 4; ++m)
#pragma unroll
                    for (int bj = 0; bj < 2; ++bj) { f32x4 v0 = acc[ai][bj][m][0], v1 = acc[ai][bj][m][1]; if (sg) { v0 = sigm4(v0); v1 = sigm4(v1); }
                        *(u32x4*)(base + (size_t)(ai * HALF + m * 16) * 1024 + bj * HALF) = pack8(v0, v1); }
        }
    }
};
struct EpiStore {
    static constexpr bool PERM = true;
    bf16_t* O; int ldc;
    __device__ __forceinline__ void operator()(const f32x4 (&acc)[2][2][4][2], const Unit& u, int wr, int wc, int fr, int fq) const {
        bf16_t* base = O + (size_t)(u.pm * BM + wr * 64 + fr) * ldc + u.pn * BM + wc * 32 + 8 * fq;
#pragma unroll
        for (int ai = 0; ai < 2; ++ai)
#pragma unroll
            for (int m = 0; m < 4; ++m)
#pragma unroll
                for (int bj = 0; bj < 2; ++bj) *(u32x4*)(base + (size_t)(ai * HALF + m * 16) * ldc + bj * HALF) = pack8(acc[ai][bj][m][0], acc[ai][bj][m][1]);
    }
};
template <bool ADD> struct EpiGate {
    static constexpr bool PERM = true;
    const bf16_t* gate; const bf16_t* add; bf16_t* O;
    __device__ __forceinline__ void operator()(const f32x4 (&acc)[2][2][4][2], const Unit& u, int wr, int wc, int fr, int fq) const {
        const size_t tile0 = (size_t)(u.pm * BM) * 1024 + u.pn * BM;
        const unsigned lo = (unsigned)((wr * 64 + fr) * 1024 + wc * 32 + 8 * fq);
#pragma unroll
        for (int ai = 0; ai < 2; ++ai) {
            u32x4 gv[4][2], av[4][2];
#pragma unroll
            for (int m = 0; m < 4; ++m)
#pragma unroll
                for (int bj = 0; bj < 2; ++bj) { const unsigned off = lo + (unsigned)((ai * HALF + m * 16) * 1024 + bj * HALF);
                    gv[m][bj] = *(const u32x4*)(gate + tile0 + off); if (ADD) av[m][bj] = *(const u32x4*)(add + tile0 + off); }
#pragma unroll
            for (int m = 0; m < 4; ++m)
#pragma unroll
                for (int bj = 0; bj < 2; ++bj) { const unsigned off = lo + (unsigned)((ai * HALF + m * 16) * 1024 + bj * HALF);
                    f32x4 g0, g1; unpack8(gv[m][bj], g0, g1);
                    f32x4 v0 = g0 * acc[ai][bj][m][0], v1 = g1 * acc[ai][bj][m][1];
                    if (ADD) { f32x4 a0, a1; unpack8(av[m][bj], a0, a1); v0 += a0; v1 += a1; }
                    *(u32x4*)(O + tile0 + off) = pack8(v0, v1); }
            asm volatile("" ::: "memory");
        }
    }
};
struct EpiRes {
    static constexpr bool PERM = true;
    const float* base_p; const float* base_s; int mp_tiles; float* hout; bf16_t* hb; float* ss;
    __device__ __forceinline__ void operator()(const f32x4 (&acc)[2][2][4][2], const Unit& u, int wr, int wc, int fr, int fq) const {
        const float* bsrc = (u.pm < mp_tiles ? base_p + (size_t)(u.pm * BM) * 1024 : base_s + (size_t)((u.pm - mp_tiles) * BM) * 1024) + u.pn * BM;
        const size_t tile0 = (size_t)(u.pm * BM) * 1024 + u.pn * BM;
        const unsigned lo = (unsigned)((wr * 64 + fr) * 1024 + wc * 32 + 8 * fq);
        float* ssr = ss + u.pm * BM + wr * 64 + fr;
#pragma unroll
        for (int ai = 0; ai < 2; ++ai) {
#pragma unroll
            for (int mh = 0; mh < 2; ++mh) {
                f32x4 bv[2][2][2];
#pragma unroll
                for (int mm = 0; mm < 2; ++mm)
#pragma unroll
                    for (int bj = 0; bj < 2; ++bj) { const unsigned off = lo + (unsigned)((ai * HALF + (mh * 2 + mm) * 16) * 1024 + bj * HALF);
                        bv[mm][bj][0] = *(const f32x4*)(bsrc + off); bv[mm][bj][1] = *(const f32x4*)(bsrc + off + 4); }
#pragma unroll
                for (int mm = 0; mm < 2; ++mm) { const int m = mh * 2 + mm; float s = 0.f;
#pragma unroll
                    for (int bj = 0; bj < 2; ++bj) { const unsigned off = lo + (unsigned)((ai * HALF + m * 16) * 1024 + bj * HALF);
                        const f32x4 h0 = bv[mm][bj][0] + acc[ai][bj][m][0], h1 = bv[mm][bj][1] + acc[ai][bj][m][1];
                        *(f32x4*)(hout + tile0 + off) = h0; *(f32x4*)(hout + tile0 + off + 4) = h1; *(u32x4*)(hb + tile0 + off) = pack8(h0, h1);
                        s += (h0[0] * h0[0] + h0[1] * h0[1]) + (h0[2] * h0[2] + h0[3] * h0[3]) + (h1[0] * h1[0] + h1[1] * h1[1]) + (h1[2] * h1[2] + h1[3] * h1[3]); }
                    s += __shfl_xor(s, 16); s += __shfl_xor(s, 32);
                    if (fq == 0) __hip_atomic_fetch_add(ssr + ai * HALF + m * 16, s, __ATOMIC_RELAXED, __HIP_MEMORY_SCOPE_AGENT); }
                asm volatile("" ::: "memory");
            }
        }
    }
};
struct EpiUp {
    static constexpr bool PERM = true;
    const float* ss; bf16_t* O;
    __device__ __forceinline__ void operator()(const f32x4 (&acc)[2][2][4][2], const Unit& u, int wr, int wc, int fr, int fq) const {
        const int row0 = u.pm * BM + wr * 64 + fr;
        bf16_t* base = O + (size_t)row0 * 4096 + u.pn * BM + wc * 32 + 8 * fq;
#pragma unroll
        for (int ai = 0; ai < 2; ++ai)
#pragma unroll
            for (int m = 0; m < 4; ++m) { const float rs = __builtin_amdgcn_rsqf(ld_agent(ss + row0 + ai * HALF + m * 16) * (1.0f / 1024.0f) + 1e-6f);
#pragma unroll
                for (int bj = 0; bj < 2; ++bj) { f32x4 v0 = acc[ai][bj][m][0] * rs, v1 = acc[ai][bj][m][1] * rs;
#pragma unroll
                    for (int j = 0; j < 4; ++j) { v0[j] = fmaxf(v0[j], 0.f); v1[j] = fmaxf(v1[j], 0.f); }
                    *(u32x4*)(base + (size_t)(ai * HALF + m * 16) * 4096 + bj * HALF) = pack8(v0 * v0, v1 * v1); } }
    }
};
struct EpiPle {
    static constexpr bool PERM = true;
    const float* ss_in; const bf16_t* PP; float* h; float* ss_out;
    __device__ __forceinline__ void operator()(const f32x4 (&acc)[2][2][4][2], const Unit& u, int wr, int wc, int fr, int fq) const {
        const size_t tile0 = (size_t)(u.pm * BM) * 1024 + u.pn * BM;
        const unsigned lo = (unsigned)((wr * 64 + fr) * 1024 + wc * 32 + 8 * fq);
        const int rowl = u.pm * BM + wr * 64 + fr;
        float rs[2][4];
#pragma unroll
        for (int ai = 0; ai < 2; ++ai)
#pragma unroll
            for (int m = 0; m < 4; ++m) rs[ai][m] = ld_agent(ss_in + rowl + ai * HALF + m * 16);
#pragma unroll
        for (int ai = 0; ai < 2; ++ai) {
#pragma unroll
            for (int mh = 0; mh < 2; ++mh) {
                f32x4 hv[2][2][2]; u32x4 pv[2][2];
#pragma unroll
                for (int mm = 0; mm < 2; ++mm)
#pragma unroll
                    for (int bj = 0; bj < 2; ++bj) { const unsigned off = lo + (unsigned)((ai * HALF + (mh * 2 + mm) * 16) * 1024 + bj * HALF);
                        hv[mm][bj][0] = *(const f32x4*)(h + tile0 + off); hv[mm][bj][1] = *(const f32x4*)(h + tile0 + off + 4); pv[mm][bj] = *(const u32x4*)(PP + tile0 + off); }
#pragma unroll
                for (int mm = 0; mm < 2; ++mm) { const int m = mh * 2 + mm; float s = 0.f;
                    const float r = __builtin_amdgcn_rsqf(rs[ai][m] * (1.0f / 1024.0f) + 1e-6f);
#pragma unroll
                    for (int bj = 0; bj < 2; ++bj) { const unsigned off = lo + (unsigned)((ai * HALF + m * 16) * 1024 + bj * HALF);
                        f32x4 p0, p1; unpack8(pv[mm][bj], p0, p1);
                        const f32x4 h0 = hv[mm][bj][0] + sigm4(acc[ai][bj][m][0] * r) * p0, h1 = hv[mm][bj][1] + sigm4(acc[ai][bj][m][1] * r) * p1;
                        *(f32x4*)(h + tile0 + off) = h0; *(f32x4*)(h + tile0 + off + 4) = h1;
                        s += (h0[0] * h0[0] + h0[1] * h0[1]) + (h0[2] * h0[2] + h0[3] * h0[3]) + (h1[0] * h1[0] + h1[1] * h1[1]) + (h1[2] * h1[2] + h1[3] * h1[3]); }
                    s += __shfl_xor(s, 16); s += __shfl_xor(s, 32);
                    if (fq == 0) __hip_atomic_fetch_add(ss_out + rowl + ai * HALF + m * 16, s, __ATOMIC_RELAXED, __HIP_MEMORY_SCOPE_AGENT); }
                asm volatile("" ::: "memory");
            }
        }
    }
};

template <class Epi, class Sched, bool ALIGN_EPI>
__device__ __forceinline__ void gemm_phase(PG8_LAS unsigned char* lds, const Gemm g, const Sched& S, const Epi& E, const int wid) {
    const int lane = fresh_lane(), tid = wid * 64 + lane, wr = wid >> 2, wc = wid & 3, fr = lane & 15, fq = lane >> 4;
    const int K = g.K, nt = K / BK;
    unsigned voffA[2], voffB[2];
#pragma unroll
    for (int i = 0; i < 2; ++i) { int R, C; stage_rc(tid * 16 + i * 8192, R, C); const int Rb = Epi::PERM ? ((R & ~31) + perm32(R & 31)) : R;
        voffA[i] = (unsigned)(R * g.lda + C) * 2u; voffB[i] = (unsigned)(Rb * g.ldb + C) * 2u; }
    const size_t kstep = (size_t)(BK * 2);
    const size_t hstepA = (size_t)HALF * g.lda * 2, hstepB = (size_t)HALF * g.ldb * 2;
    const size_t tstepA = 2 * hstepA, tstepB = 2 * hstepB, pnA = (size_t)g.a_pn_off * 2;
    const unsigned ldsw = (unsigned)wid * 1024u;
    const int aoff = lds_byte(wr * 64 + fr, fq * 8), boff = lds_byte(wc * 32 + fr, fq * 8);
#define PG8_SA(b, h) (((b) * 2 + (h)) * HTB)
#define PG8_SB(b, h) ((4 + (b) * 2 + (h)) * HTB)
#define PG8_STAGE(bufoff, gbase, voff) do { _Pragma("unroll") for (int _i = 0; _i < 2; ++_i) \
        __builtin_amdgcn_global_load_lds((const unsigned*)((const char*)(gbase) + (voff)[_i]), (PG8_LAS unsigned*)(lds + (bufoff) + ldsw + _i * 8192), 16, 0, 0); } while (0)
#define PG8_LDA(dst, b, h) do { _Pragma("unroll") for (int m = 0; m < 4; ++m) _Pragma("unroll") for (int k = 0; k < 2; ++k) dst[m][k] = *(const PG8_LAS bf16x8*)(lds + PG8_SA(b, h) + aoff + m * 2048 + k * 1024); } while (0)
#define PG8_LDB(dst, b, h) do { _Pragma("unroll") for (int n = 0; n < 2; ++n) _Pragma("unroll") for (int k = 0; k < 2; ++k) dst[n][k] = *(const PG8_LAS bf16x8*)(lds + PG8_SB(b, h) + boff + n * 2048 + k * 1024); } while (0)
#define PG8_MMA(ai, bj, At, Bt) do { __builtin_amdgcn_s_setprio(1); _Pragma("unroll") for (int m = 0; m < 4; ++m) _Pragma("unroll") for (int n = 0; n < 2; ++n) _Pragma("unroll") for (int k = 0; k < 2; ++k) \
        acc[ai][bj][m][n] = __builtin_amdgcn_mfma_f32_16x16x32_bf16(Bt[n][k], At[m][k], acc[ai][bj][m][n], 0, 0, 0); __builtin_amdgcn_s_setprio(0); } while (0)
#define PG8_WAIT_V(n) asm volatile("s_waitcnt vmcnt(" #n ")" ::: "memory")
#define PG8_WAIT_L(n) asm volatile("s_waitcnt lgkmcnt(" #n ")" ::: "memory")
#define PG8_BAR __builtin_amdgcn_s_barrier()
#define PG8_SCHED __builtin_amdgcn_sched_barrier(0)
    Unit cur, nxt; int ui = 0;
    if (!S.next(0, cur)) return;
    f32x4 acc[2][2][4][2];
#pragma unroll
    for (int a = 0; a < 2; ++a)
#pragma unroll
        for (int b = 0; b < 2; ++b)
#pragma unroll
            for (int m = 0; m < 4; ++m)
#pragma unroll
                for (int n = 0; n < 2; ++n) acc[a][b][m][n] = (f32x4){0.f, 0.f, 0.f, 0.f};
    bf16x8 At[4][2], B0[2][2], B1[2][2];
    const char* cA = (const char*)g.A + (size_t)cur.pm * tstepA + (size_t)cur.pn * pnA; const char* cB = (const char*)g.Bt + (size_t)cur.pn * tstepB;
    PG8_STAGE(PG8_SB(0, 0), cB, voffB); PG8_STAGE(PG8_SB(0, 1), cB + hstepB, voffB); PG8_STAGE(PG8_SA(0, 0), cA, voffA); PG8_STAGE(PG8_SA(0, 1), cA + hstepA, voffA);
    if (wr == 1) PG8_BAR;
    PG8_WAIT_V(2); PG8_BAR;
    PG8_STAGE(PG8_SB(1, 0), cB + kstep, voffB); PG8_STAGE(PG8_SA(1, 0), cA + kstep, voffA); PG8_STAGE(PG8_SB(1, 1), cB + hstepB + kstep, voffB);
    PG8_WAIT_V(6); PG8_BAR;
    for (;;) {
        const bool has_next = S.next(ui + 1, nxt);
        const char* nA = has_next ? (const char*)g.A + (size_t)nxt.pm * tstepA + (size_t)nxt.pn * pnA : cA; const char* nB = has_next ? (const char*)g.Bt + (size_t)nxt.pn * tstepB : cB;
        for (int t = 0; t < nt; t += 2) {
            const bool last = (t == nt - 2);
            const char* a1 = cA + (size_t)(t + 1) * kstep;
            const char* a2 = last ? nA : cA + (size_t)(t + 2) * kstep; const char* b2 = last ? nB : cB + (size_t)(t + 2) * kstep;
            const char* a3 = a2 + kstep; const char* b3 = b2 + kstep;
            PG8_LDB(B0, 0, 0); PG8_LDB(B1, 0, 1); PG8_SCHED; PG8_LDA(At, 0, 0); PG8_STAGE(PG8_SA(1, 1), a1 + hstepA, voffA);
            PG8_WAIT_V(8); PG8_WAIT_L(0); PG8_BAR; PG8_MMA(0, 0, At, B0); PG8_MMA(0, 1, At, B1); PG8_BAR; PG8_SCHED;
            PG8_LDA(At, 0, 1); PG8_STAGE(PG8_SB(0, 0), b2, voffB); PG8_STAGE(PG8_SB(0, 1), b2 + hstepB, voffB); PG8_STAGE(PG8_SA(0, 0), a2, voffA);
            PG8_WAIT_V(8); PG8_WAIT_L(0); PG8_BAR; PG8_MMA(1, 0, At, B0); PG8_MMA(1, 1, At, B1); PG8_BAR; PG8_SCHED;
            PG8_LDB(B0, 1, 0); PG8_LDB(B1, 1, 1); PG8_SCHED; PG8_LDA(At, 1, 0); PG8_STAGE(PG8_SA(0, 1), a2 + hstepA, voffA);
            PG8_WAIT_V(8); PG8_WAIT_L(0); PG8_BAR; PG8_MMA(0, 0, At, B0); PG8_MMA(0, 1, At, B1); PG8_BAR; PG8_SCHED;
            PG8_LDA(At, 1, 1); PG8_STAGE(PG8_SB(1, 0), b3, voffB); PG8_STAGE(PG8_SB(1, 1), b3 + hstepB, voffB); PG8_STAGE(PG8_SA(1, 0), a3, voffA);
            PG8_WAIT_V(8); PG8_WAIT_L(0); PG8_BAR; PG8_MMA(1, 0, At, B0); PG8_MMA(1, 1, At, B1); PG8_BAR; PG8_SCHED;
        }
        if constexpr (ALIGN_EPI) { if (wr == 0) PG8_BAR; }
        { int fr_e = fr, fq_e = fq; asm volatile("" : "+v"(fr_e), "+v"(fq_e));
          E(acc, cur, wr, wc, fr_e, fq_e); }
        if (!has_next) break;
#pragma unroll
        for (int a = 0; a < 2; ++a)
#pragma unroll
            for (int b = 0; b < 2; ++b)
#pragma unroll
                for (int m = 0; m < 4; ++m)
#pragma unroll
                    for (int n = 0; n < 2; ++n) acc[a][b][m][n] = (f32x4){0.f, 0.f, 0.f, 0.f};
        cur = nxt; cA = nA; cB = nB; ++ui;
        if constexpr (ALIGN_EPI) { if (wr == 1) PG8_BAR; }
    }
    PG8_WAIT_V(0);
    if constexpr (!ALIGN_EPI) { if (wr == 0) PG8_BAR; }
    PG8_BAR;
#undef PG8_SA
#undef PG8_SB
#undef PG8_STAGE
#undef PG8_LDA
#undef PG8_LDB
#undef PG8_MMA
#undef PG8_WAIT_V
#undef PG8_WAIT_L
#undef PG8_BAR
#undef PG8_SCHED
}
}


namespace mini {
using namespace pg8;
template <int WMG, int WNG, int WKG, int RT, int CT, int K, class Epi>
__device__ __forceinline__ void tile(PG8_LAS unsigned char* lds, const bf16_t* A, int lda, const bf16_t* Bt, int ldb, int row0, int col0, const Epi& E, const int wid) {
    static_assert(WMG * WNG * WKG == 8, "8 waves");
    constexpr int Kw = K / WKG, NS = Kw / 32, PF = NS < 4 ? NS : 4;
    static_assert(NS % PF == 0, "K-steps divide into ring rounds");
    const int lane = fresh_lane(), fr = lane & 15, fq = lane >> 4;
    const int kg = wid / (WMG * WNG), wmn = wid % (WMG * WNG), wm = wmn / WNG, wn = wmn % WNG;
    const int r0 = row0 + wm * RT * 16, c0 = col0 + wn * CT * 16;
    const bf16_t* ap = A + (size_t)(r0 + fr) * lda + kg * Kw + fq * 8;
    const bf16_t* bp = Bt + (size_t)(c0 + fr) * ldb + kg * Kw + fq * 8;
    f32x4 acc[RT][CT];
#pragma unroll
    for (int m = 0; m < RT; ++m)
#pragma unroll
        for (int n = 0; n < CT; ++n) acc[m][n] = (f32x4){0.f, 0.f, 0.f, 0.f};
    bf16x8 a[PF][RT], b[PF][CT];
#pragma unroll
    for (int st = 0; st < PF; ++st) {
#pragma unroll
        for (int m = 0; m < RT; ++m) a[st][m] = *(const bf16x8*)(ap + (size_t)m * 16 * lda + st * 32);
#pragma unroll
        for (int n = 0; n < CT; ++n) b[st][n] = *(const bf16x8*)(bp + (size_t)n * 16 * ldb + st * 32);
    }
    for (int k = 0; k < NS; k += PF) {
#pragma unroll
        for (int st = 0; st < PF; ++st) {
#pragma unroll
            for (int m = 0; m < RT; ++m)
#pragma unroll
                for (int n = 0; n < CT; ++n) acc[m][n] = __builtin_amdgcn_mfma_f32_16x16x32_bf16(b[st][n], a[st][m], acc[m][n], 0, 0, 0);
            if (k + PF + st < NS) {
                const int ko = (k + PF + st) * 32;
#pragma unroll
                for (int m = 0; m < RT; ++m) a[st][m] = *(const bf16x8*)(ap + (size_t)m * 16 * lda + ko);
#pragma unroll
                for (int n = 0; n < CT; ++n) b[st][n] = *(const bf16x8*)(bp + (size_t)n * 16 * ldb + ko);
            }
            __builtin_amdgcn_sched_barrier(0);
        }
    }
    if constexpr (WKG > 1) {
        PG8_LAS f32x4* red = (PG8_LAS f32x4*)lds;
        if (kg > 0) {
#pragma unroll
            for (int m = 0; m < RT; ++m)
#pragma unroll
                for (int n = 0; n < CT; ++n) red[(((kg - 1) * (WMG * WNG) + wmn) * (RT * CT) + m * CT + n) * 64 + lane] = acc[m][n];
        }
        __syncthreads();
        if (kg == 0) {
#pragma unroll
            for (int g = 0; g < WKG - 1; ++g)
#pragma unroll
                for (int m = 0; m < RT; ++m)
#pragma unroll
                    for (int n = 0; n < CT; ++n) acc[m][n] += red[((g * (WMG * WNG) + wmn) * (RT * CT) + m * CT + n) * 64 + lane];
        }
    }
    if (kg == 0) {
#pragma unroll
        for (int m = 0; m < RT; ++m) E(r0 + m * 16 + fr, c0 + 4 * fq, acc[m], fq);
    }
    if constexpr (WKG > 1) __syncthreads();
}
__device__ __forceinline__ unsigned long long pack4(const f32x4 v) { return (unsigned long long)cvt_pk_bf16(v[0], v[1]) | ((unsigned long long)cvt_pk_bf16(v[2], v[3]) << 32); }
__device__ __forceinline__ f32x4 unpack4(const unsigned long long w) { f32x4 v; const unsigned lo = (unsigned)w, hi = (unsigned)(w >> 32);
    v[0] = __uint_as_float(lo << 16); v[1] = __uint_as_float(lo & 0xffff0000u); v[2] = __uint_as_float(hi << 16); v[3] = __uint_as_float(hi & 0xffff0000u); return v; }
struct EStore { bf16_t* O; int ldc;
    template <int CT> __device__ __forceinline__ void operator()(int row, int col, const f32x4 (&v)[CT], int) const {
#pragma unroll
        for (int n = 0; n < CT; ++n) *(unsigned long long*)(O + (size_t)row * ldc + col + 16 * n) = pack4(v[n]); } };
template <bool ADD> struct EGate { const bf16_t* gate; const bf16_t* add; bf16_t* O;
    template <int CT> __device__ __forceinline__ void operator()(int row, int col, const f32x4 (&v)[CT], int) const {
#pragma unroll
        for (int n = 0; n < CT; ++n) { const size_t off = (size_t)row * 1024 + col + 16 * n; f32x4 o = unpack4(*(const unsigned long long*)(gate + off)) * v[n];
            if (ADD) o += unpack4(*(const unsigned long long*)(add + off)); *(unsigned long long*)(O + off) = pack4(o); } } };
struct ERes { const float* base; int base_row0; float* hout; bf16_t* hb; float* ss;
    template <int CT> __device__ __forceinline__ void operator()(int row, int col, const f32x4 (&v)[CT], int fq) const { float s = 0.f;
#pragma unroll
        for (int n = 0; n < CT; ++n) { const size_t off = (size_t)row * 1024 + col + 16 * n; const f32x4 h = *(const f32x4*)(base + (size_t)(row - base_row0) * 1024 + col + 16 * n) + v[n];
            *(f32x4*)(hout + off) = h; *(unsigned long long*)(hb + off) = pack4(h); s += (h[0] * h[0] + h[1] * h[1]) + (h[2] * h[2] + h[3] * h[3]); }
        s += __shfl_xor(s, 16); s += __shfl_xor(s, 32);
        if (fq == 0) __hip_atomic_fetch_add(ss + row, s, __ATOMIC_RELAXED, __HIP_MEMORY_SCOPE_AGENT); } };
struct EUp { const float* ss; bf16_t* O;
    template <int CT> __device__ __forceinline__ void operator()(int row, int col, const f32x4 (&v)[CT], int) const {
        const float rs = __builtin_amdgcn_rsqf(ld_agent(ss + row) * (1.0f / 1024.0f) + 1e-6f);
#pragma unroll
        for (int n = 0; n < CT; ++n) { f32x4 o = v[n] * rs;
#pragma unroll
            for (int j = 0; j < 4; ++j) o[j] = fmaxf(o[j], 0.f);
            *(unsigned long long*)(O + (size_t)row * 4096 + col + 16 * n) = pack4(o * o); } } };
struct EPle { const float* ss_in; const bf16_t* PP; float* h; float* ss_out;
    template <int CT> __device__ __forceinline__ void operator()(int row, int col, const f32x4 (&v)[CT], int fq) const { float s = 0.f;
        const float rs = __builtin_amdgcn_rsqf(ld_agent(ss_in + row) * (1.0f / 1024.0f) + 1e-6f);
#pragma unroll
        for (int n = 0; n < CT; ++n) { const size_t off = (size_t)row * 1024 + col + 16 * n; const f32x4 hv = *(const f32x4*)(h + off) + sigm4(v[n] * rs) * unpack4(*(const unsigned long long*)(PP + off));
            *(f32x4*)(h + off) = hv; s += (hv[0] * hv[0] + hv[1] * hv[1]) + (hv[2] * hv[2] + hv[3] * hv[3]); }
        s += __shfl_xor(s, 16); s += __shfl_xor(s, 32);
        if (fq == 0) __hip_atomic_fetch_add(ss_out + row, s, __ATOMIC_RELAXED, __HIP_MEMORY_SCOPE_AGENT); } };
}

constexpr int NWAVES = 8;
constexpr int D = 1024, MP = 8 * 2048, MS = 128 * 8, M = MP + MS, NIN = 6144, FF = 4096, PLE = 256, SEQ = 2048, DSEQ = 8, PBUF = 15;
constexpr float EPS = 1e-6f;
constexpr int N_LAUNCHES = MK_N_LAUNCHES, N_PHASES = 9;
constexpr size_t O_Y = 0, O_NCP = (size_t)M * D, O_NPP = O_NCP + 8 * 2 * D, O_NCS = O_NPP + 8 * 15 * D, O_NPS = O_NCS + 128 * 2 * D, O_END = O_NPS + 128 * 15 * D;
constexpr size_t MiB = 1u << 20, SB = (size_t)M * D * 2;
constexpr size_t WS_CTL = 0, CTL_ZERO_BYTES = 1 * MiB;
constexpr size_t WS_SS = 512 * 1024;
constexpr size_t WS_WIN = 1 * MiB, WS_WCO = 13 * MiB, WS_WO = 15 * MiB, WS_WG = 17 * MiB, WS_WUP = 19 * MiB, WS_WDN = 27 * MiB, WS_WPOOL = 35 * MiB, WS_WP = WS_WPOOL + 512 * 1024;
constexpr size_t WS_PBF = 36 * MiB;
constexpr size_t WS_PP = 45 * MiB, WS_HB = WS_PP + SB, WS_XN = WS_HB + SB, WS_B = WS_XN + SB, WS_U = WS_B + SB, WS_V = WS_U + SB, WS_END = WS_V + SB;
constexpr size_t WS_ZS = WS_HB;
constexpr size_t WS_ACT = WS_XN;
static_assert(WS_SS + 3 * (size_t)M * 4 <= CTL_ZERO_BYTES && WS_PBF + (size_t)M * PLE * 2 <= WS_PP && WS_END <= 256 * MiB, "d_ws map");
constexpr int CW_BAR = 4096;
constexpr int RING_OFF = 0, RING_BYTES = 131072, LDSCTL_OFF = RING_BYTES, MISC_OFF = LDSCTL_OFF + 320, LDS_BYTES = 147456;

#define GAS __attribute__((address_space(1)))
#define LAS __attribute__((address_space(3)))
typedef unsigned short bf16;
typedef unsigned v4u __attribute__((ext_vector_type(4)));
typedef float f32x4 __attribute__((ext_vector_type(4)));
typedef GAS unsigned gu32;
#define LDS_WAIT() asm volatile("s_waitcnt lgkmcnt(0)" ::: "memory")
__device__ __forceinline__ unsigned f2bf(float f) { unsigned u = __builtin_bit_cast(unsigned, f); return (u + 0x7fffu + ((u >> 16) & 1u)) >> 16; }
__device__ __forceinline__ unsigned pk2(float lo, float hi) { return f2bf(lo) | (f2bf(hi) << 16); }

#define XB_TMO      128
#define XB_XCNT(j)  (256  + 64 * (j))
#define XB_XSUB(j)  (1280 + 64 * (j))
#define XB_XGEN(j)  (2304 + 64 * (j))
#define XB_TOP      3328
#define XB_TOPGEN   3392
#define XCD_BAR_WORDS 3456
#define XB_SPIN_CAP (1u << 18)
__device__ __forceinline__ unsigned xb_ld(unsigned* p)              { return __hip_atomic_load(p, __ATOMIC_RELAXED, __HIP_MEMORY_SCOPE_AGENT); }
__device__ __forceinline__ unsigned xb_add(unsigned* p, unsigned v) { return __hip_atomic_fetch_add(p, v, __ATOMIC_RELAXED, __HIP_MEMORY_SCOPE_AGENT); }
__device__ __forceinline__ unsigned xb_xcc_id() { return (unsigned)__builtin_amdgcn_s_getreg((3 << 11) | 20) & 0xFu; }
#define XB_SPIN(cond, bar) do { unsigned _sp = 0; while (cond) { __builtin_amdgcn_s_sleep(1); \
    if ((++_sp & 255u) == 0u) { if (xb_ld(&(bar)[XB_TMO])) break; if (_sp > XB_SPIN_CAP) { atomicAdd(&(bar)[XB_TMO], 1u); break; } } } } while (0)
struct XcdBarrier { unsigned* bar; unsigned x; volatile LAS unsigned* st; };
__device__ __forceinline__ XcdBarrier xcd_barrier_post(unsigned* bar, volatile LAS unsigned* st) {
    XcdBarrier b; b.bar = bar; b.x = xb_xcc_id(); b.st = st;
    if (threadIdx.x == 0) (void)xb_add(&bar[XB_XCNT(b.x)], 1u);
    return b;
}
__device__ __forceinline__ void xcd_barrier_complete(unsigned* bar, unsigned x, unsigned& nloc, unsigned& nx) {
    const unsigned G = gridDim.x * gridDim.y * gridDim.z;
    unsigned sum, cnt, mine, sp = 0u;
    for (;;) {
        sum = 0u; cnt = 0u; mine = 0u;
#pragma unroll
        for (unsigned j = 0; j < 16; ++j) { const unsigned c = xb_ld(&bar[XB_XCNT(j)]); sum += c; cnt += (c > 0u) ? 1u : 0u; mine = (j == x) ? c : mine; }
        if (sum == G) break;
        __builtin_amdgcn_s_sleep(1);
        if ((++sp & 255u) == 0u) { if (xb_ld(&bar[XB_TMO])) break; if (sp > XB_SPIN_CAP) { atomicAdd(&bar[XB_TMO], 1u); break; } }
    }
    nloc = mine > 0u ? mine : 1u; nx = cnt > 0u ? cnt : 1u;
}
__device__ __forceinline__ void xcd_barrier(const XcdBarrier& b, const int wave) {
    asm volatile("s_waitcnt vmcnt(0)" ::: "memory");
    __syncthreads();
    if (wave == 0 && pg8::fresh_lane() == 0) {
        unsigned* bar = b.bar;
        __builtin_amdgcn_s_waitcnt(0);
        unsigned nloc = b.st[0], nx = b.st[1];
        if (nloc == 0u) { xcd_barrier_complete(bar, b.x, nloc, nx); b.st[0] = nloc; b.st[1] = nx; }
        const unsigned old = xb_add(&bar[XB_XSUB(b.x)], 1u);
        const unsigned gen = old / nloc;
        if (old + 1u == (gen + 1u) * nloc) {
            __builtin_amdgcn_fence(__ATOMIC_RELEASE, "agent");
            asm volatile("s_waitcnt vmcnt(0)" ::: "memory");
            const unsigned og = xb_add(&bar[XB_TOP], 1u);
            const unsigned tg = og / nx;
            if (og + 1u == (tg + 1u) * nx) xb_add(&bar[XB_TOPGEN], 1u);
            else XB_SPIN(xb_ld(&bar[XB_TOPGEN]) == tg, bar);
            __builtin_amdgcn_fence(__ATOMIC_ACQUIRE, "agent");
            xb_add(&bar[XB_XGEN(b.x)], 1u);
            asm volatile("s_waitcnt vmcnt(0)" ::: "memory");
        } else {
            XB_SPIN(xb_ld(&bar[XB_XGEN(b.x)]) == gen, bar);
            __builtin_amdgcn_fence(__ATOMIC_ACQUIRE, "agent");
            asm volatile("s_waitcnt vmcnt(0)" ::: "memory");
        }
    }
    __syncthreads();
}

struct Frame {
    LAS unsigned char* lds;
    volatile LAS unsigned* MISC;
    gu32* ctl;
    int wave, vcu, G;
};
__device__ __forceinline__ float wave_sum(float v) {
#pragma unroll
    for (int o = 1; o < 64; o <<= 1) v += __shfl_xor(v, o);
    return v;
}
__device__ __forceinline__ void p0_transpose_item(const float* W, int N, bf16* WT, int ldwt, int row_off, const float* sk, const float* sn, LAS float* scr, int kb, int nb, int lane) {
    const int k0 = 64 * kb, n0 = 32 * nb;
    const float snv = sn ? sn[n0 + (lane & 31)] : 1.0f;
#pragma unroll 8
    for (int i = 0; i < 32; ++i) { const int kk = 2 * i + (lane >> 5); const float skv = sk ? sk[k0 + kk] : 1.0f; scr[kk * 33 + (lane & 31)] = W[(size_t)(k0 + kk) * N + n0 + (lane & 31)] * skv * snv; }
    LDS_WAIT(); asm volatile("" ::: "memory");
    const int c = lane & 7;
#pragma unroll
    for (int j = 0; j < 4; ++j) { const int n = (lane >> 3) + 8 * j; const LAS float* s = scr + (8 * c) * 33 + n;
        v4u o; o.x = pk2(s[0 * 33], s[1 * 33]); o.y = pk2(s[2 * 33], s[3 * 33]); o.z = pk2(s[4 * 33], s[5 * 33]); o.w = pk2(s[6 * 33], s[7 * 33]);
        *(GAS v4u*)(WT + (size_t)(row_off + n0 + n) * ldwt + k0 + 8 * c) = o; }
    LDS_WAIT(); asm volatile("" ::: "memory");
}

struct Args { const float* in[20]; float* out; unsigned char* ws; int ph_lo, ph_hi, li, pad; };

__device__ __forceinline__ void p0_prologue(Frame& F, const Args& a) {
    LAS float* scr = (LAS float*)(F.lds + RING_OFF + F.wave * 16384);
    const int lane = pg8::fresh_lane();
    const int gw = F.vcu * NWAVES + F.wave, NGW = F.G * NWAVES;
    unsigned char* ws = a.ws;
    constexpr int I_IN = 16 * (NIN / 32), I_SQ = 16 * 32, I_UP = 16 * (FF / 32), I_DN = 64 * 32, I_PL = 4 * 4 * 8, I_PP = 4 * 32;
    constexpr int NITEMS = I_IN + 3 * I_SQ + I_UP + I_DN + I_PL + I_PP;
    for (int it = gw; it < NITEMS; it += NGW) {
        int r = it;
        if (r < I_IN) {
            const int nblk = NIN / 32, kb = r / nblk, nb = r % nblk, n0 = 32 * nb; int ro;
            if (n0 < 1024 || n0 >= 3072) ro = 0; else if (n0 < 2048) { const int j = n0 - 1024; ro = (1024 + (j >> 7) * 256 + (j & 127)) - n0; } else { const int j = n0 - 2048; ro = (1024 + (j >> 7) * 256 + 128 + (j & 127)) - n0; }
            p0_transpose_item(a.in[7], NIN, (bf16*)(ws + WS_WIN), D, ro, a.in[6], nullptr, scr, kb, nb, lane); continue; } r -= I_IN;
        if (r < I_SQ) { p0_transpose_item(a.in[9], D, (bf16*)(ws + WS_WCO), D, 0, nullptr, nullptr, scr, r / 32, r % 32, lane); continue; } r -= I_SQ;
        if (r < I_SQ) { p0_transpose_item(a.in[12], D, (bf16*)(ws + WS_WO), D, 0, nullptr, nullptr, scr, r / 32, r % 32, lane); continue; } r -= I_SQ;
        if (r < I_SQ) { p0_transpose_item(a.in[17], D, (bf16*)(ws + WS_WG), D, 0, a.in[16], nullptr, scr, r / 32, r % 32, lane); continue; } r -= I_SQ;
        if (r < I_UP) { p0_transpose_item(a.in[14], FF, (bf16*)(ws + WS_WUP), D, 0, a.in[13], nullptr, scr, r / (FF / 32), r % (FF / 32), lane); continue; } r -= I_UP;
        if (r < I_DN) { p0_transpose_item(a.in[15], D, (bf16*)(ws + WS_WDN), FF, 0, nullptr, nullptr, scr, r / 32, r % 32, lane); continue; } r -= I_DN;
        if (r < I_PL) { const int g = r / 32, q = r % 32;
            p0_transpose_item(a.in[10] + (size_t)g * 65536, 256, (bf16*)(ws + WS_WPOOL), 256, g * 256, nullptr, a.in[11] + g * 256, scr, q / 8, q % 8, lane); continue; } r -= I_PL;
        p0_transpose_item(a.in[18], D, (bf16*)(ws + WS_WP), PLE, 0, nullptr, nullptr, scr, r / 32, r % 32, lane);
    }
    bf16* XN = (bf16*)(ws + WS_XN);
    for (int m = gw; m < M; m += NGW) {
        const float* xrow = m < MP ? a.in[0] + (size_t)m * D : a.in[1] + (size_t)(m - MP) * D;
        const GAS f32x4* xr = (const GAS f32x4*)xrow + lane;
        f32x4 v[4]; float s = 0.f;
#pragma unroll
        for (int j = 0; j < 4; ++j) { v[j] = xr[64 * j]; s += (v[j].x * v[j].x + v[j].y * v[j].y) + (v[j].z * v[j].z + v[j].w * v[j].w); }
        const float rstd = 1.0f / sqrtf(wave_sum(s) * (1.f / D) + EPS);
        GAS unsigned long long* o8 = (GAS unsigned long long*)(XN + (size_t)m * D) + lane;
#pragma unroll
        for (int j = 0; j < 4; ++j) o8[64 * j] = (unsigned long long)pk2(v[j].x * rstd, v[j].y * rstd) | ((unsigned long long)pk2(v[j].z * rstd, v[j].w * rstd) << 32);
    }
    bf16* PB = (bf16*)(ws + WS_PBF);
    for (int m = gw; m < M; m += NGW) {
        const float* prow = m < MP ? a.in[4] + (size_t)m * PLE : a.in[5] + (size_t)(m - MP) * PLE;
        const f32x4 v = ((const GAS f32x4*)prow)[lane];
        ((GAS unsigned long long*)(PB + (size_t)m * PLE))[lane] = (unsigned long long)pk2(v.x, v.y) | ((unsigned long long)pk2(v.z, v.w) << 32);
    }
}

template <int W> __device__ __forceinline__ void p2_mixer_rows(bf16* Bb, const bf16* Ub, const bf16* Vb, bf16* PO, const float* wconv, float* out, const int r0, const int c0) {
    const f32x4 z4 = (f32x4){0.f, 0.f, 0.f, 0.f};
    const f32x4 w0a = *(const f32x4*)(wconv + c0), w0b = *(const f32x4*)(wconv + c0 + 4), w1a = *(const f32x4*)(wconv + D + c0), w1b = *(const f32x4*)(wconv + D + c0 + 4), w2a = *(const f32x4*)(wconv + 2 * D + c0), w2b = *(const f32x4*)(wconv + 2 * D + c0 + 4);
    const int t0 = r0 & (SEQ - 1), sq = r0 >> 11;
    const size_t ro0 = (size_t)r0 * D + c0;
    f32x4 sa = z4, sb = z4, u1a = z4, u1b = z4, u2a = z4, u2b = z4;
    if (t0 > 0) {
        v4u raw[W];
#pragma unroll
        for (int j = 0; j < W; ++j) raw[j] = *(const v4u*)(Vb + ro0 - (size_t)(j + 1) * D);
        const v4u r1 = *(const v4u*)(Ub + ro0 - D), r2 = *(const v4u*)(Ub + ro0 - 2 * D);
#pragma unroll
        for (int j = 0; j < W; ++j) { f32x4 xa, xb; pg8::unpack8(raw[j], xa, xb); sa += xa; sb += xb; }
        pg8::unpack8(r1, u1a, u1b); pg8::unpack8(r2, u2a, u2b);
    }
#pragma unroll 4
    for (int i = 0; i < 16; ++i) {
        const int t = t0 + i; const size_t ro = ro0 + (size_t)i * D;
        const v4u rb = *(const v4u*)(Bb + ro), ru = *(const v4u*)(Ub + ro), rv = *(const v4u*)(Vb + ro);
        v4u rold = (v4u){0u, 0u, 0u, 0u}; if (t >= W) rold = *(const v4u*)(Vb + ro - (size_t)W * D);
        f32x4 b0, b1, u0a, u0b, v0a, v0b, oa, ob;
        pg8::unpack8(rb, b0, b1); pg8::unpack8(ru, u0a, u0b); pg8::unpack8(rv, v0a, v0b); pg8::unpack8(rold, oa, ob);
        const f32x4 ya = u2a * w0a + u1a * w1a + u0a * w2a, yb = u2b * w0b + u1b * w1b + u0b * w2b;
        *(v4u*)(Bb + ro) = pg8::pack8(b0 * ya, b1 * yb);
        u2a = u1a; u2b = u1b; u1a = u0a; u1b = u0b;
        sa += v0a - oa; sb += v0b - ob;
        const float ic = 1.0f / (float)(W < t + 1 ? W : t + 1);
        *(v4u*)(PO + ro) = pg8::pack8(sa * ic - v0a, sb * ic - v0b);
        if (t >= SEQ - 2) { float* o = out + O_NCP + ((size_t)sq * 2 + (t - (SEQ - 2))) * D + c0; *(f32x4*)o = u0a; *(f32x4*)(o + 4) = u0b; }
        if (t >= SEQ - PBUF) { float* o = out + O_NPP + ((size_t)sq * PBUF + (t - (SEQ - PBUF))) * D + c0; *(f32x4*)o = v0a; *(f32x4*)(o + 4) = v0b; }
    }
}
__device__ __forceinline__ void p2_mixer(Frame& F, const Args& a) {
    unsigned char* ws = a.ws;
    bf16* Bb = (bf16*)(ws + WS_B); const bf16* Ub = (const bf16*)(ws + WS_U); const bf16* Vb = (const bf16*)(ws + WS_V); bf16* PO = (bf16*)(ws + WS_XN);
    const int lane = pg8::fresh_lane();
    const int grp = F.wave & 3, c0 = (grp * 32 + (lane & 31)) * 8, rsub = (F.wave >> 2) * 2 + (lane >> 5);
    for (int blk = F.vcu; blk < MP / 64; blk += F.G) {
        const int r0 = blk * 64 + rsub * 16;
        if (grp == 0) p2_mixer_rows<2>(Bb, Ub, Vb, PO, a.in[8], a.out, r0, c0);
        else if (grp == 1) p2_mixer_rows<4>(Bb, Ub, Vb, PO, a.in[8], a.out, r0, c0);
        else if (grp == 2) p2_mixer_rows<8>(Bb, Ub, Vb, PO, a.in[8], a.out, r0, c0);
        else p2_mixer_rows<16>(Bb, Ub, Vb, PO, a.in[8], a.out, r0, c0);
    }
}

__device__ __forceinline__ void p2_mixer_sample(Frame& F, const Args& a) {
    unsigned char* ws = a.ws;
    const bf16* ZS = (const bf16*)(ws + WS_ZS); bf16* Bb = (bf16*)(ws + WS_B); bf16* PO = (bf16*)(ws + WS_XN); bf16* GAo = (bf16*)a.out; bf16* GBo = GAo + (size_t)M * D;
    const float* wconv = a.in[8]; const float* sconv = a.in[2]; const float* spool = a.in[3]; float* out = a.out;
    const int tid_ = F.wave * 64 + pg8::fresh_lane();
    for (int it = F.vcu * (NWAVES * 64) + tid_; it < MS * 128; it += F.G * NWAVES * 64) {
        const int rs = it >> 7, cc = it & 127, c0 = cc * 8, grp = cc >> 5, w = 2 << grp, t = rs & 7, sq = rs >> 3;
        const int cu = 1024 + (c0 >> 7) * 256 + (c0 & 127);
        const bf16* zr = ZS + (size_t)rs * NIN;
        f32x4 b0, b1, ua[3], ub[3];
        pg8::unpack8(*(const v4u*)(zr + c0), b0, b1);
#pragma unroll
        for (int j = 0; j < 3; ++j) {
            if (t - j >= 0) { f32x4 ca, cb, ha, hb; pg8::unpack8(*(const v4u*)(zr - (size_t)j * NIN + cu), ca, cb); pg8::unpack8(*(const v4u*)(zr - (size_t)j * NIN + cu + 128), ha, hb); ua[j] = ca * ha; ub[j] = cb * hb; }
            else { const float* p = sconv + ((size_t)sq * 2 + (2 + t - j)) * D + c0; ua[j] = *(const f32x4*)p; ub[j] = *(const f32x4*)(p + 4); }
        }
        const f32x4 ya = ua[2] * *(const f32x4*)(wconv + c0) + ua[1] * *(const f32x4*)(wconv + D + c0) + ua[0] * *(const f32x4*)(wconv + 2 * D + c0);
        const f32x4 yb = ub[2] * *(const f32x4*)(wconv + c0 + 4) + ub[1] * *(const f32x4*)(wconv + D + c0 + 4) + ub[0] * *(const f32x4*)(wconv + 2 * D + c0 + 4);
        const size_t ro = (size_t)(MP + rs) * D + c0;
        *(v4u*)(Bb + ro) = pg8::pack8(b0 * ya, b1 * yb);
        f32x4 v0a, v0b; pg8::unpack8(*(const v4u*)(zr + 3072 + c0), v0a, v0b);
        f32x4 sa = v0a, sb = v0b;
        {
            v4u zr_[7]; f32x4 pa_[15], pb_[15];
#pragma unroll
            for (int j = 1; j <= 7; ++j) { const int tj = t - j >= 0 ? t - j : 0; zr_[j - 1] = *(const v4u*)(zr + (ptrdiff_t)(tj - t) * NIN + 3072 + c0); }
#pragma unroll
            for (int j = 1; j <= 15; ++j) { int bi = PBUF + t - j; bi = bi < 0 ? 0 : (bi > PBUF - 1 ? PBUF - 1 : bi); const float* p = spool + ((size_t)sq * PBUF + bi) * D + c0; pa_[j - 1] = *(const f32x4*)p; pb_[j - 1] = *(const f32x4*)(p + 4); }
#pragma unroll
            for (int j = 1; j <= 15; ++j) {
                f32x4 xa = pa_[j - 1], xb = pb_[j - 1];
                if (j <= 7) { f32x4 za, zb; pg8::unpack8(zr_[j - 1], za, zb); const bool inz = t - j >= 0; xa = inz ? za : xa; xb = inz ? zb : xb; }
                const float mk = j < w ? 1.0f : 0.0f;
                sa += xa * mk; sb += xb * mk;
            }
        }
        const float ic = 1.0f / (float)w;
        *(v4u*)(PO + ro) = pg8::pack8(sa * ic - v0a, sb * ic - v0b);
        { f32x4 g0, g1; pg8::unpack8(*(const v4u*)(zr + 4096 + c0), g0, g1); *(v4u*)(GAo + ro) = pg8::pack8(pg8::sigm4(g0), pg8::sigm4(g1));
          pg8::unpack8(*(const v4u*)(zr + 5120 + c0), g0, g1); *(v4u*)(GBo + ro) = pg8::pack8(pg8::sigm4(g0), pg8::sigm4(g1)); }
        if (t >= DSEQ - 2) { float* o = out + O_NCS + ((size_t)sq * 2 + (t - (DSEQ - 2))) * D + c0; *(f32x4*)o = ua[0]; *(f32x4*)(o + 4) = ub[0]; }
        { float* o = out + O_NPS + ((size_t)sq * PBUF + (PBUF - DSEQ + t)) * D + c0; *(f32x4*)o = v0a; *(f32x4*)(o + 4) = v0b; }
        if (t < PBUF - DSEQ) { const float* p = spool + ((size_t)sq * PBUF + DSEQ + t) * D + c0; float* o = out + O_NPS + ((size_t)sq * PBUF + t) * D + c0; *(f32x4*)o = *(const f32x4*)p; *(f32x4*)(o + 4) = *(const f32x4*)(p + 4); }
    }
}

__device__ __forceinline__ void p8_final(Frame& F, const Args& a) {
    const int lane = pg8::fresh_lane();
    const int gw = F.vcu * NWAVES + F.wave, NGW = F.G * NWAVES;
    const float* ss = (const float*)(a.ws + WS_SS) + 2 * M; const float* gf = a.in[19];
    f32x4 g[4];
#pragma unroll
    for (int j = 0; j < 4; ++j) g[j] = ((const f32x4*)gf)[lane + 64 * j];
    for (int m = gw; m < M; m += NGW) {
        const float rs = 1.0f / sqrtf(pg8::ld_agent(ss + m) * (1.f / D) + EPS);
        GAS f32x4* hr = (GAS f32x4*)(a.out + (size_t)m * D) + lane;
#pragma unroll
        for (int j = 0; j < 4; ++j) hr[64 * j] = hr[64 * j] * rs * g[j];
    }
}

__global__ void __launch_bounds__(NWAVES * 64, 2) mega_fwd(Args args) {
    extern __shared__ __attribute__((aligned(16))) unsigned char lds[];
    Frame F;
    F.lds = (LAS unsigned char*)lds;
    F.MISC = (volatile LAS unsigned*)(F.lds + MISC_OFF);
    F.wave = __builtin_amdgcn_readfirstlane(threadIdx.x >> 6);
    F.G = gridDim.x; { const int bx = blockIdx.x; F.vcu = (F.G % 8 == 0) ? (bx % 8) * (F.G / 8) + bx / 8 : bx; }
    unsigned char* ws = args.ws;
    F.ctl = (gu32*)(ws + WS_CTL);
    for (int u = threadIdx.x; u < (LDS_BYTES - LDSCTL_OFF) / 4; u += NWAVES * 64) ((LAS unsigned*)(F.lds + LDSCTL_OFF))[u] = 0u;
    __syncthreads();
    XcdBarrier bar; bar.bar = (unsigned*)(F.ctl + CW_BAR); bar.x = 0; bar.st = nullptr;
    if (N_LAUNCHES == 1) bar = xcd_barrier_post((unsigned*)(F.ctl + CW_BAR), F.MISC + 8);
    const int lo = args.ph_lo, hi = args.ph_hi;
#define IN(k) (lo <= (k) && (k) < hi)
#define SEAM(k) do { if (IN(k) && IN((k) + 1)) xcd_barrier(bar, F.wave); } while (0)
    using namespace pg8;
    bf16_t* const W_IN = (bf16_t*)(ws + WS_WIN); bf16_t* const W_CO = (bf16_t*)(ws + WS_WCO); bf16_t* const W_O = (bf16_t*)(ws + WS_WO); bf16_t* const W_G = (bf16_t*)(ws + WS_WG);
    bf16_t* const W_UP = (bf16_t*)(ws + WS_WUP); bf16_t* const W_DN = (bf16_t*)(ws + WS_WDN); bf16_t* const W_PL = (bf16_t*)(ws + WS_WPOOL); bf16_t* const W_P = (bf16_t*)(ws + WS_WP);
    bf16_t* const PBF = (bf16_t*)(ws + WS_PBF); bf16_t* const PPB = (bf16_t*)(ws + WS_PP); bf16_t* const HB = (bf16_t*)(ws + WS_HB); bf16_t* const XN = (bf16_t*)(ws + WS_XN);
    bf16_t* const BB = (bf16_t*)(ws + WS_B); bf16_t* const UB = (bf16_t*)(ws + WS_U); bf16_t* const VB = (bf16_t*)(ws + WS_V); bf16_t* const ACT = (bf16_t*)(ws + WS_ACT);
    bf16_t* const GA = (bf16_t*)args.out; bf16_t* const GBB = GA + (size_t)M * D;
    float* const SS = (float*)(ws + WS_SS); float* const HOUT = args.out + O_Y;
    LAS unsigned char* ring = F.lds + RING_OFF;
    const int cid = (int)blockIdx.x;

    bf16_t* const ZS = (bf16_t*)(ws + WS_ZS);
    const int vt = F.vcu;
    if (IN(0)) { p0_prologue(F, args); SEAM(0); }
    if (IN(1)) {
        { Gemm g{XN, W_IN, D, D, D, 0}; StaticOrder S; S.init(MP, NIN, F.G, cid); EpiIn E{BB, UB, VB, GA, GBB}; gemm_phase<EpiIn, StaticOrder, true>(ring, g, S, E, F.wave); }
        { Gemm g{PBF, W_P, PLE, PLE, PLE, 0}; StaticOrder S; S.init(MP, D, F.G, cid); EpiStore E{PPB, D}; gemm_phase<EpiStore, StaticOrder, true>(ring, g, S, E, F.wave); }
        for (int t = vt; t < 8 * 32; t += F.G) { mini::EStore E{ZS, NIN}; mini::tile<2, 4, 1, 4, 3, D>(ring, XN + (size_t)MP * D, D, W_IN, D, (t >> 5) * 128, (t & 31) * 192, E, F.wave); }
        for (int t = vt; t < 16 * 16; t += F.G) { mini::EStore E{PPB + (size_t)MP * D, D}; mini::tile<1, 2, 4, 4, 2, PLE>(ring, PBF + (size_t)MP * PLE, PLE, W_P, PLE, (t >> 4) * 64, (t & 15) * 64, E, F.wave); }
        SEAM(1);
    }
    if (IN(2)) { p2_mixer(F, args); p2_mixer_sample(F, args); SEAM(2); }
    if (IN(3)) {
        { Gemm g{XN, W_PL, 256, D, 256, 256}; StaticOrder S; S.init(MP, D, F.G, cid); EpiGate<false> E{GBB, nullptr, UB}; gemm_phase<EpiGate<false>, StaticOrder, true>(ring, g, S, E, F.wave); }
        { Gemm g{BB, W_CO, D, D, D, 0}; StaticOrder S; S.init(MP, D, F.G, cid); EpiGate<true> E{GA, UB, VB}; gemm_phase<EpiGate<true>, StaticOrder, true>(ring, g, S, E, F.wave); }
        for (int t = vt; t < 16 * 16; t += F.G) { const int r0 = MP + (t >> 4) * 64, c0 = (t & 15) * 64;
            { mini::EGate<false> E{GBB, nullptr, UB}; mini::tile<1, 2, 4, 4, 2, 256>(ring, XN + (c0 & ~255), D, W_PL, 256, r0, c0, E, F.wave); }
            { mini::EGate<true> E{GA, UB, VB}; mini::tile<1, 2, 4, 4, 2, D>(ring, BB, D, W_CO, D, r0, c0, E, F.wave); } }
        SEAM(3);
    }
    if (IN(4)) { { Gemm g{VB, W_O, D, D, D, 0}; StaticOrder S; S.init(MP, D, F.G, cid); EpiRes E{args.in[0], args.in[1], MP / 256, HOUT, HB, SS}; gemm_phase<EpiRes, StaticOrder, true>(ring, g, S, E, F.wave); }
        for (int t = vt; t < 16 * 16; t += F.G) { mini::ERes E{args.in[1], MP, HOUT, HB, SS}; mini::tile<1, 2, 4, 4, 2, D>(ring, VB, D, W_O, D, MP + (t >> 4) * 64, (t & 15) * 64, E, F.wave); }
        SEAM(4); }
    if (IN(5)) { { Gemm g{HB, W_UP, D, D, D, 0}; StaticOrder S; S.init(MP, FF, F.G, cid); EpiUp E{SS, ACT}; gemm_phase<EpiUp, StaticOrder, true>(ring, g, S, E, F.wave); }
        for (int t = vt; t < 8 * 32; t += F.G) { mini::EUp E{SS, ACT}; mini::tile<2, 4, 1, 4, 2, D>(ring, HB, D, W_UP, D, MP + (t >> 5) * 128, (t & 31) * 128, E, F.wave); }
        SEAM(5); }
    if (IN(6)) { { Gemm g{ACT, W_DN, FF, FF, FF, 0}; StaticOrder S; S.init(MP, D, F.G, cid); EpiRes E{HOUT, HOUT + (size_t)MP * D, MP / 256, HOUT, HB, SS + M}; gemm_phase<EpiRes, StaticOrder, true>(ring, g, S, E, F.wave); }
        for (int t = vt; t < 16 * 16; t += F.G) { mini::ERes E{HOUT, 0, HOUT, HB, SS + M}; mini::tile<1, 2, 4, 4, 2, FF>(ring, ACT, FF, W_DN, FF, MP + (t >> 4) * 64, (t & 15) * 64, E, F.wave); }
        SEAM(6); }
    if (IN(7)) { { Gemm g{HB, W_G, D, D, D, 0}; StaticOrder S; S.init(MP, D, F.G, cid); EpiPle E{SS + M, PPB, HOUT, SS + 2 * M}; gemm_phase<EpiPle, StaticOrder, true>(ring, g, S, E, F.wave); }
        for (int t = vt; t < 16 * 16; t += F.G) { mini::EPle E{SS + M, PPB, HOUT, SS + 2 * M}; mini::tile<1, 2, 4, 4, 2, D>(ring, HB, D, W_G, D, MP + (t >> 4) * 64, (t & 15) * 64, E, F.wave); }
        SEAM(7); }
    if (IN(8)) { p8_final(F, args); }
#undef IN
#undef SEAM
}

extern "C" void kernel_launch(void* const* d_in, const int* in_sizes, int n_in, void* d_out, int out_size, void* d_ws, size_t ws_size, hipStream_t stream) {
    static int grid = 0;
    if (grid == 0) {
        if (n_in != 20 || in_sizes[0] != MP * D || in_sizes[1] != MS * D || (size_t)out_size != O_END || ws_size < WS_END) {
            fprintf(stderr, "kernel_launch: unexpected shapes (n_in %d, in0 %d, out %d, ws %zu); nothing launched\n", n_in, n_in > 0 ? in_sizes[0] : -1, out_size, ws_size); grid = -1; return; }
        int dev = 0, cus = 0, per_cu = 0;
        if (hipGetDevice(&dev) != hipSuccess || hipDeviceGetAttribute(&cus, hipDeviceAttributeMultiprocessorCount, dev) != hipSuccess) { grid = -1; return; }
        if (hipFuncSetAttribute((const void*)mega_fwd, hipFuncAttributeMaxDynamicSharedMemorySize, LDS_BYTES) != hipSuccess) { fprintf(stderr, "kernel_launch: hipFuncSetAttribute failed\n"); grid = -1; return; }
        if (hipOccupancyMaxActiveBlocksPerMultiprocessor(&per_cu, (const void*)mega_fwd, NWAVES * 64, LDS_BYTES) != hipSuccess || per_cu < 1) { fprintf(stderr, "kernel_launch: occupancy query reports %d workgroups per CU\n", per_cu); }
        (void)hipGetLastError();
        grid = cus;
    }
    if (grid < 0) return;
    if (hipMemsetAsync((char*)d_ws + WS_CTL, 0, CTL_ZERO_BYTES, stream) != hipSuccess) return;
    Args a{};
    for (int i = 0; i < 20; ++i) a.in[i] = (const float*)d_in[i];
    a.out = (float*)d_out; a.ws = (unsigned char*)d_ws;
    for (int li = 0; li < N_LAUNCHES; ++li) {
        a.ph_lo = (N_LAUNCHES == 1) ? 0 : li; a.ph_hi = (N_LAUNCHES == 1) ? N_PHASES : li + 1; a.li = li;
        hipLaunchKernelGGL(mega_fwd, dim3(grid), dim3(NWAVES * 64), LDS_BYTES, stream, a);
    }
}
```
